# Optimizing an MI355X kernel written in HIP

```python
import math
import jax, jax.numpy as jnp
from jax import lax
import numpy as np

D_MODEL = 1024
BATCH = 16
SEQ = 2048
DEPTH = 1

HEAD_DIM = 64
HEADS_PER_GROUP = 8
DILATED_GROUPS = ((128, 1), (512, 4), (2048, 16))
N_ATTN_HEADS = HEADS_PER_GROUP * len(DILATED_GROUPS)
ATTN_QKV_WIDTH = N_ATTN_HEADS * HEAD_DIM
ATTN_OUT_WIDTH = HEADS_PER_GROUP * HEAD_DIM
N_FOURIER_GROUPS = 4
FOURIER_GROUP_DIM = 128
FOURIER_WIDTH = N_FOURIER_GROUPS * FOURIER_GROUP_DIM
D_FF = 4 * D_MODEL
NUM_BUCKETS = 32
REL_MAX_DISTANCE = 1024
Q_OFF = 0
K_OFF = Q_OFF + ATTN_QKV_WIDTH
V_OFF = K_OFF + ATTN_QKV_WIDTH
F_OFF = V_OFF + ATTN_QKV_WIDTH
GA_OFF = F_OFF + FOURIER_WIDTH
GF_OFF = GA_OFF + D_MODEL
IN_WIDTH = GF_OFF + D_MODEL
DEEPNORM_ALPHA = (2 * DEPTH) ** 0.25
DEEPNORM_BETA = (8 * DEPTH) ** -0.25
LN_EPS = 1e-5
NEG_INF = -1e30

kernel_name = "hybrid_fourier_dilated_attn_encoder"


def _layer_norm(x, g, b):
    xf = x.astype(jnp.float32)
    mu = jnp.mean(xf, axis=-1, keepdims=True)
    var = jnp.mean(jnp.square(xf - mu), axis=-1, keepdims=True)
    return ((xf - mu) * lax.rsqrt(var + LN_EPS) * g.astype(jnp.float32) + b.astype(jnp.float32)).astype(x.dtype)


def _t5_buckets(rel):
    half = NUM_BUCKETS // 2
    ret = np.where(rel > 0, half, 0)
    n = np.abs(rel)
    max_exact = half // 2
    n_f = np.maximum(n, 1).astype(np.float32)
    large = max_exact + (np.log(n_f / max_exact) / math.log(REL_MAX_DISTANCE / max_exact) * (half - max_exact)).astype(np.int32)
    large = np.minimum(large, half - 1)
    return (ret + np.where(n < max_exact, n, large)).astype(np.int32)


def _dilated_window_attention(q, k, v, bias_table, window, dilation):
    B, S, H, Dh = q.shape
    d = dilation
    R = window // (2 * d)
    L = S // d
    nb = -(-L // R)
    Lp = nb * R
    pad = Lp - L

    def split(t):
        return t.reshape(B, L, d, H, Dh).transpose(0, 2, 3, 1, 4)

    qs = jnp.pad(split(q), ((0, 0), (0, 0), (0, 0), (0, pad), (0, 0)))
    qb = qs.reshape(B, d, H, nb, R, Dh)

    def band(t):
        t = jnp.pad(split(t), ((0, 0), (0, 0), (0, 0), (R, R + pad), (0, 0)))
        t = t.reshape(B, d, H, nb + 2, R, Dh)
        return jnp.concatenate([t[:, :, :, :-2], t[:, :, :, 1:-1], t[:, :, :, 2:]], axis=4)

    kb, vb = band(k), band(v)

    s_idx = np.arange(R)[:, None]
    t_idx = np.arange(3 * R)[None, :]
    rel = t_idx - R - s_idx
    k_pos = (np.arange(nb)[:, None] - 1) * R + np.arange(3 * R)[None, :]
    valid = (np.abs(rel)[None] <= R) & ((k_pos >= 0) & (k_pos < L))[:, None, :]
    buckets = _t5_buckets(rel * d)
    bias = jnp.transpose(bias_table[buckets].astype(jnp.float32), (2, 0, 1))

    logits = jnp.einsum('bghnqd,bghnkd->bghnqk', qb, kb).astype(jnp.float32) * (Dh ** -0.5)
    logits = logits + bias[None, None, :, None]
    logits = jnp.where(jnp.asarray(valid)[None, None, None], logits, NEG_INF)
    m = jnp.max(logits, axis=-1, keepdims=True)
    p = jnp.exp(logits - m)
    denom = jnp.sum(p, axis=-1, keepdims=True)
    out = jnp.einsum('bghnqk,bghnkd->bghnqd', p, vb.astype(jnp.float32)) / denom
    lse = (m + jnp.log(denom))[..., 0]

    out = out.reshape(B, d, H, Lp, Dh)[:, :, :, :L].transpose(0, 3, 1, 2, 4).reshape(B, S, H, Dh)
    lse = lse.reshape(B, d, H, Lp)[:, :, :, :L].transpose(0, 3, 1, 2).reshape(B, S, H)
    return out, lse


def _fourier_mix(u):
    B, S, _ = u.shape
    ug = u.astype(jnp.float32).reshape(B, S, N_FOURIER_GROUPS, FOURIER_GROUP_DIM)
    f = jnp.real(jnp.fft.fft2(ug, axes=(1, 3), norm="ortho"))
    return f.reshape(B, S, FOURIER_WIDTH).astype(u.dtype)


def _token_mixing(x, rel_bias, w_in, w_fourier_out, w_attn_out, w_out):
    B, S, _ = x.shape
    proj = jnp.einsum('bsd,de->bse', x, w_in)
    q = proj[..., Q_OFF:K_OFF].reshape(B, S, N_ATTN_HEADS, HEAD_DIM)
    k = proj[..., K_OFF:V_OFF].reshape(B, S, N_ATTN_HEADS, HEAD_DIM)
    v = proj[..., V_OFF:F_OFF].reshape(B, S, N_ATTN_HEADS, HEAD_DIM)
    u_f = proj[..., F_OFF:GA_OFF]
    gate_a = jax.nn.sigmoid(proj[..., GA_OFF:GF_OFF])
    gate_f = jax.nn.sigmoid(proj[..., GF_OFF:IN_WIDTH])

    outs, lses = [], []
    for g, (window, dilation) in enumerate(DILATED_GROUPS):
        hs = slice(g * HEADS_PER_GROUP, (g + 1) * HEADS_PER_GROUP)
        o, l = _dilated_window_attention(q[:, :, hs], k[:, :, hs], v[:, :, hs], rel_bias[:, hs], window, dilation)
        outs.append(o)
        lses.append(l)
    weights = jax.nn.softmax(jnp.stack(lses, axis=0), axis=0)[..., None]
    attn = jnp.sum(weights * jnp.stack(outs, axis=0), axis=0).reshape(B, S, ATTN_OUT_WIDTH).astype(x.dtype)
    y_attn = jnp.einsum('bse,ed->bsd', attn, w_attn_out)

    y_four = jnp.einsum('bse,ed->bsd', _fourier_mix(u_f), w_fourier_out)

    merged = gate_a * y_attn + gate_f * y_four
    return jnp.einsum('bsd,de->bse', merged, w_out)


def _sq_relu_mlp(x, w_up, b_up, w_down, b_down):
    h = jnp.square(jax.nn.relu(jnp.einsum('bsd,df->bsf', x, w_up) + b_up))
    return jnp.einsum('bsf,fd->bsd', h, w_down) + b_down


def setup_inputs(seed: int = 0) -> dict:
    key = jax.random.key(seed)
    ks = jax.random.split(key, 16)
    f32 = jnp.float32
    nrm = lambda k, shape, scale: jax.random.normal(k, shape, f32) * scale
    return {
        "x": nrm(ks[0], (BATCH, SEQ, D_MODEL), 1.0),
        "rel_bias": nrm(ks[1], (NUM_BUCKETS, N_ATTN_HEADS), 0.1),
        "w_in": nrm(ks[2], (DEPTH, D_MODEL, IN_WIDTH), D_MODEL ** -0.5),
        "w_fourier_out": nrm(ks[3], (DEPTH, FOURIER_WIDTH, D_MODEL), DEEPNORM_BETA * FOURIER_WIDTH ** -0.5),
        "w_attn_out": nrm(ks[4], (DEPTH, ATTN_OUT_WIDTH, D_MODEL), DEEPNORM_BETA * ATTN_OUT_WIDTH ** -0.5),
        "w_out": nrm(ks[5], (DEPTH, D_MODEL, D_MODEL), DEEPNORM_BETA * D_MODEL ** -0.5),
        "ln1_g": 1.0 + nrm(ks[6], (DEPTH, D_MODEL), 0.02),
        "ln1_b": nrm(ks[7], (DEPTH, D_MODEL), 0.02),
        "w_up": nrm(ks[8], (DEPTH, D_MODEL, D_FF), D_MODEL ** -0.5),
        "b_up": nrm(ks[9], (DEPTH, D_FF), 0.02),
        "w_down": nrm(ks[10], (DEPTH, D_FF, D_MODEL), DEEPNORM_BETA * D_FF ** -0.5),
        "b_down": nrm(ks[11], (DEPTH, D_MODEL), 0.02),
        "ln2_g": 1.0 + nrm(ks[12], (DEPTH, D_MODEL), 0.02),
        "ln2_b": nrm(ks[13], (DEPTH, D_MODEL), 0.02),
    }


def reference(x, rel_bias, w_in, w_fourier_out, w_attn_out, w_out, ln1_g, ln1_b, w_up, b_up, w_down, b_down, ln2_g, ln2_b):
    h = x
    for layer in range(DEPTH):
        mix = _token_mixing(h, rel_bias, w_in[layer], w_fourier_out[layer], w_attn_out[layer], w_out[layer])
        h = _layer_norm(DEEPNORM_ALPHA * h + mix, ln1_g[layer], ln1_b[layer])
        ff = _sq_relu_mlp(h, w_up[layer], b_up[layer], w_down[layer], b_down[layer])
        h = _layer_norm(DEEPNORM_ALPHA * h + ff, ln2_g[layer], ln2_b[layer])
    return h
```

```cpp
#include <hip/hip_runtime.h>
#include <cstdio>
#include <cstdint>
#define MK_N_LAUNCHES 1
#define USE_SIMPLE_GEMM 0
namespace pg8 {
#define PG8_LAS __attribute__((address_space(3)))
typedef unsigned short bf16_t;
typedef short bf16x8 __attribute__((ext_vector_type(8)));
typedef float f32x4 __attribute__((ext_vector_type(4)));
typedef unsigned u32x4 __attribute__((ext_vector_type(4)));
constexpr int BM = 256, BK = 64, HALF = 128, HTB = HALF * BK * 2  , STAGE_BYTES = 8 * HTB, NXCD = 8, WGM = 8;

__host__ __device__ __forceinline__ int lds_byte(int r, int c) { const int st = (r >> 4) * 2 + (c >> 5), rr = r & 15, cc = c & 31, ob = rr * 64 + cc * 2; return st * 1024 + (ob ^ (((ob >> 9) & 1) << 5)); }
__host__ __device__ __forceinline__ void stage_rc(int b, int& R, int& C) { const int st = b / 1024, sb = b % 1024, swz = sb ^ (((sb >> 9) & 1) << 5); R = (st >> 1) * 16 + swz / 64; C = (st & 1) * 32 + (swz % 64) / 2; }
__host__ __device__ __forceinline__ int perm32(int rho) { const int n = rho >> 4, i = rho & 15; return 8 * (i >> 2) + 4 * n + (i & 3); }

struct Unit { int pm, pn; };
struct Gemm { const bf16_t* A; const bf16_t* Bt; int M, N, K; };

struct StaticOrder {
    int nM, nN, nwg, G, c;
    __host__ __device__ void init(int M, int N, int G_, int c_) { nM = M / BM; nN = N / BM; nwg = nM * nN; G = G_; c = c_; }
    __host__ __device__ bool next(int i, Unit& u) const {
        const long L = (long)i * G + c; if (L >= nwg) return false;
        int wgid = (int)L; { const int q = nwg / NXCD, r = nwg % NXCD, xcd = wgid % NXCD, off = wgid / NXCD; wgid = (xcd < r ? xcd * (q + 1) : r * (q + 1) + (xcd - r) * q) + off; }
        const int nig = WGM * nN, gid = wgid / nig, fm = gid * WGM, gsz = (nM - fm) < WGM ? (nM - fm) : WGM;
        u.pm = fm + ((wgid % nig) % gsz); u.pn = (wgid % nig) / gsz; return true;
    }
    __device__ __forceinline__ void a_ready(const Unit&) const {}
    __device__ __forceinline__ void done(const Unit&) const {}
};
typedef float f32x2 __attribute__((ext_vector_type(2)));
typedef __bf16 bf16x2_t __attribute__((ext_vector_type(2)));
__device__ __forceinline__ unsigned cvt_pk_bf16(float lo, float hi) { f32x2 v = {lo, hi}; bf16x2_t b = __builtin_convertvector(v, bf16x2_t); return __builtin_bit_cast(unsigned, b); }
template <class F> struct EpiAdapt {
    static constexpr bool PERM = F::PERM, AFTER_DRAIN = false; F f;
    __device__ __forceinline__ void operator()(const f32x4 (&acc)[2][2][4][2], const Unit& u, int wr, int wc, int fr, int fq) const {
        const int row0 = u.pm * BM + wr * 64 + fr;
        if constexpr (F::PERM) {
            const int col0 = u.pn * BM + wc * 32 + 8 * fq;
#pragma unroll
            for (int ai = 0; ai < 2; ++ai)
#pragma unroll
                for (int m = 0; m < 4; ++m)
#pragma unroll
                    for (int bj = 0; bj < 2; ++bj) f.oct(row0 + ai * HALF + m * 16, col0 + bj * HALF, acc[ai][bj][m][0], acc[ai][bj][m][1]);
        } else {
            const int col0 = u.pn * BM + wc * 32 + 4 * fq;
#pragma unroll
            for (int ai = 0; ai < 2; ++ai)
#pragma unroll
                for (int m = 0; m < 4; ++m)
#pragma unroll
                    for (int bj = 0; bj < 2; ++bj)
#pragma unroll
                        for (int n = 0; n < 2; ++n) f.quad(row0 + ai * HALF + m * 16, col0 + bj * HALF + n * 16, acc[ai][bj][m][n]);
        }
    }
};
template <class Epi, class Sched, bool ALIGN_EPI = false, bool SP2 = false>
__device__ __forceinline__ void gemm_phase(PG8_LAS unsigned char* lds, const Gemm g, const Sched& S, const Epi& E) {
    const int tid = threadIdx.x, wid = __builtin_amdgcn_readfirstlane(tid >> 6), lane = tid & 63, wr = wid >> 2, wc = wid & 3, fr = lane & 15, fq = lane >> 4;
    const int K = g.K, nt = K / BK;
    unsigned voffA[2], voffB[2];
#pragma unroll
    for (int i = 0; i < 2; ++i) { int R, C; stage_rc(tid * 16 + i * 8192, R, C); const int Rb = Epi::PERM ? ((R & ~31) + perm32(R & 31)) : R;
        voffA[i] = (unsigned)(R * K + C) * 2u; voffB[i] = (unsigned)(Rb * K + C) * 2u; }
    const size_t kstep = (size_t)(BK * 2);
    const size_t hstep = (size_t)HALF * K * 2;
    const size_t tstep = 2 * hstep;
    const unsigned ldsw = (unsigned)wid * 1024u;
    const int aoff = lds_byte(wr * 64 + fr, fq * 8), boff = lds_byte(wc * 32 + fr, fq * 8);
#define PG8_SA(b, h) (((b) * 2 + (h)) * HTB)
#define PG8_SB(b, h) ((4 + (b) * 2 + (h)) * HTB)
#define PG8_STAGE(bufoff, gbase, voff) do { _Pragma("unroll") for (int _i = 0; _i < 2; ++_i) \
        __builtin_amdgcn_global_load_lds((const unsigned*)((const char*)(gbase) + (voff)[_i]), (PG8_LAS unsigned*)(lds + (bufoff) + ldsw + _i * 8192), 16, 0, 0); } while (0)
#define PG8_LDA(dst, b, h) do { _Pragma("unroll") for (int m = 0; m < 4; ++m) _Pragma("unroll") for (int k = 0; k < 2; ++k) dst[m][k] = *(const PG8_LAS bf16x8*)(lds + PG8_SA(b, h) + aoff + m * 2048 + k * 1024); } while (0)
#define PG8_LDB(dst, b, h) do { _Pragma("unroll") for (int n = 0; n < 2; ++n) _Pragma("unroll") for (int k = 0; k < 2; ++k) dst[n][k] = *(const PG8_LAS bf16x8*)(lds + PG8_SB(b, h) + boff + n * 2048 + k * 1024); } while (0)
#define PG8_MMA(ai, bj, At, Bt) do { __builtin_amdgcn_s_setprio(1); _Pragma("unroll") for (int m = 0; m < 4; ++m) _Pragma("unroll") for (int n = 0; n < 2; ++n) _Pragma("unroll") for (int k = 0; k < 2; ++k) \
        acc[ai][bj][m][n] = __builtin_amdgcn_mfma_f32_16x16x32_bf16(Bt[n][k], At[m][k], acc[ai][bj][m][n], 0, 0, 0); __builtin_amdgcn_s_setprio(0); } while (0)
#define PG8_WAIT_V(n) asm volatile("s_waitcnt vmcnt(" #n ")" ::: "memory")
#define PG8_WAIT_L(n) asm volatile("s_waitcnt lgkmcnt(" #n ")" ::: "memory")
#define PG8_BAR __builtin_amdgcn_s_barrier()
#define PG8_SCHED __builtin_amdgcn_sched_barrier(0)
    Unit cur, nxt; int ui = 0;
    if (!S.next(0, cur)) return;
    f32x4 acc[2][2][4][2];
#pragma unroll
    for (int a = 0; a < 2; ++a)
#pragma unroll
        for (int b = 0; b < 2; ++b)
#pragma unroll
            for (int m = 0; m < 4; ++m)
#pragma unroll
                for (int n = 0; n < 2; ++n) acc[a][b][m][n] = (f32x4){0.f, 0.f, 0.f, 0.f};
    bf16x8 At[4][2], B0[2][2], B1[2][2];
    const char* cA = (const char*)g.A + (size_t)cur.pm * tstep; const char* cB = (const char*)g.Bt + (size_t)cur.pn * tstep;
    S.a_ready(cur);
    if constexpr (SP2) {
        PG8_STAGE(PG8_SB(0, 0), cB, voffB); PG8_STAGE(PG8_SB(0, 1), cB + hstep, voffB); PG8_STAGE(PG8_SA(0, 0), cA, voffA); PG8_STAGE(PG8_SA(0, 1), cA + hstep, voffA);
        if (wr == 1) PG8_BAR;
        PG8_WAIT_V(2); PG8_BAR;
        PG8_STAGE(PG8_SB(1, 0), cB + kstep, voffB); PG8_STAGE(PG8_SA(1, 0), cA + kstep, voffA); PG8_STAGE(PG8_SB(1, 1), cB + hstep + kstep, voffB);
        PG8_WAIT_V(6); PG8_BAR;
    } else {
        PG8_STAGE(PG8_SB(0, 0), cB, voffB); PG8_STAGE(PG8_SA(0, 0), cA, voffA); PG8_STAGE(PG8_SB(0, 1), cB + hstep, voffB); PG8_STAGE(PG8_SA(0, 1), cA + hstep, voffA);
        if (wr == 1) PG8_BAR;
        PG8_WAIT_V(4); PG8_BAR;
        PG8_STAGE(PG8_SB(1, 0), cB + kstep, voffB); PG8_STAGE(PG8_SA(1, 0), cA + kstep, voffA); PG8_STAGE(PG8_SB(1, 1), cB + hstep + kstep, voffB);
        PG8_WAIT_V(6); PG8_BAR;
    }
    for (;;) {
        const bool has_next = S.next(ui + 1, nxt);
        const char* nA = has_next ? (const char*)g.A + (size_t)nxt.pm * tstep : cA; const char* nB = has_next ? (const char*)g.Bt + (size_t)nxt.pn * tstep : cB;
        for (int t = 0; t < nt; t += 2) {
            const bool last = (t == nt - 2);
            const char* a1 = cA + (size_t)(t + 1) * kstep;
            const char* a2 = last ? nA : cA + (size_t)(t + 2) * kstep; const char* b2 = last ? nB : cB + (size_t)(t + 2) * kstep;
            const char* a3 = a2 + kstep; const char* b3 = b2 + kstep;
            if (last && has_next) S.a_ready(nxt);
            if constexpr (SP2) {
            PG8_LDB(B0, 0, 0); PG8_LDB(B1, 0, 1); PG8_SCHED; PG8_LDA(At, 0, 0); PG8_STAGE(PG8_SA(1, 1), a1 + hstep, voffA);
            PG8_WAIT_V(8); PG8_WAIT_L(0); PG8_BAR; PG8_MMA(0, 0, At, B0); PG8_MMA(0, 1, At, B1); PG8_BAR; PG8_SCHED;
            PG8_LDA(At, 0, 1); PG8_STAGE(PG8_SB(0, 0), b2, voffB); PG8_STAGE(PG8_SB(0, 1), b2 + hstep, voffB); PG8_STAGE(PG8_SA(0, 0), a2, voffA);
            PG8_WAIT_V(8); PG8_WAIT_L(0); PG8_BAR; PG8_MMA(1, 0, At, B0); PG8_MMA(1, 1, At, B1); PG8_BAR; PG8_SCHED;
            PG8_LDB(B0, 1, 0); PG8_LDB(B1, 1, 1); PG8_SCHED; PG8_LDA(At, 1, 0); PG8_STAGE(PG8_SA(0, 1), a2 + hstep, voffA);
            PG8_WAIT_V(8); PG8_WAIT_L(0); PG8_BAR; PG8_MMA(0, 0, At, B0); PG8_MMA(0, 1, At, B1); PG8_BAR; PG8_SCHED;
            PG8_LDA(At, 1, 1); PG8_STAGE(PG8_SB(1, 0), b3, voffB); PG8_STAGE(PG8_SB(1, 1), b3 + hstep, voffB); PG8_STAGE(PG8_SA(1, 0), a3, voffA);
            PG8_WAIT_V(8); PG8_WAIT_L(0); PG8_BAR; PG8_MMA(1, 0, At, B0); PG8_MMA(1, 1, At, B1); PG8_BAR; PG8_SCHED;
            } else {
            PG8_LDB(B0, 0, 0); PG8_SCHED; PG8_LDA(At, 0, 0); PG8_STAGE(PG8_SA(1, 1), a1 + hstep, voffA);
            PG8_WAIT_L(8); PG8_BAR; PG8_WAIT_L(0); PG8_MMA(0, 0, At, B0); PG8_BAR; PG8_SCHED;
            PG8_LDB(B1, 0, 1); PG8_STAGE(PG8_SB(0, 0), b2, voffB);
            PG8_BAR; PG8_WAIT_L(0); PG8_MMA(0, 1, At, B1); PG8_BAR;
            PG8_LDA(At, 0, 1); PG8_STAGE(PG8_SA(0, 0), a2, voffA);
            PG8_BAR; PG8_WAIT_L(0); PG8_MMA(1, 0, At, B0); PG8_BAR; PG8_SCHED;
            PG8_STAGE(PG8_SB(0, 1), b2 + hstep, voffB);
            PG8_WAIT_V(6); PG8_BAR; PG8_MMA(1, 1, At, B1); PG8_BAR;
            PG8_LDB(B0, 1, 0); PG8_SCHED; PG8_LDA(At, 1, 0); PG8_STAGE(PG8_SA(0, 1), a2 + hstep, voffA);
            PG8_WAIT_L(8); PG8_BAR; PG8_WAIT_L(0); PG8_MMA(0, 0, At, B0); PG8_BAR; PG8_SCHED;
            PG8_LDB(B1, 1, 1); PG8_STAGE(PG8_SB(1, 0), b3, voffB);
            PG8_BAR; PG8_WAIT_L(0); PG8_MMA(0, 1, At, B1); PG8_BAR;
            PG8_LDA(At, 1, 1); PG8_STAGE(PG8_SA(1, 0), a3, voffA);
            PG8_BAR; PG8_WAIT_L(0); PG8_MMA(1, 0, At, B0); PG8_BAR; PG8_SCHED;
            PG8_STAGE(PG8_SB(1, 1), b3 + hstep, voffB);
            PG8_WAIT_V(6); PG8_BAR; PG8_MMA(1, 1, At, B1); PG8_BAR;
            }
        }
        if constexpr (ALIGN_EPI) { if (wr == 0) PG8_BAR; }
        if constexpr (!Epi::AFTER_DRAIN) { E(acc, cur, wr, wc, fr, fq); S.done(cur); }
        if (!has_next) break;
#pragma unroll
        for (int a = 0; a < 2; ++a)
#pragma unroll
            for (int b = 0; b < 2; ++b)
#pragma unroll
                for (int m = 0; m < 4; ++m)
#pragma unroll
                    for (int n = 0; n < 2; ++n) acc[a][b][m][n] = (f32x4){0.f, 0.f, 0.f, 0.f};
        cur = nxt; cA = nA; cB = nB; ++ui;
        if constexpr (ALIGN_EPI) { if (wr == 1) PG8_BAR; }
    }
    PG8_WAIT_V(0);
    if constexpr (!ALIGN_EPI) { if (wr == 0) PG8_BAR; }
    PG8_BAR;
    if constexpr (Epi::AFTER_DRAIN) { E.fused(acc, cur, wr, wc, fr, fq, lds, wid, lane); S.done(cur); }
#undef PG8_SA
#undef PG8_SB
#undef PG8_STAGE
#undef PG8_LDA
#undef PG8_LDB
#undef PG8_MMA
#undef PG8_WAIT_V
#undef PG8_WAIT_L
#undef PG8_BAR
#undef PG8_SCHED
}
}
#define GAS __attribute__((address_space(1)))
#define LAS __attribute__((address_space(3)))
typedef unsigned short bf16;
typedef unsigned v4u __attribute__((ext_vector_type(4)));
typedef float f32x4 __attribute__((ext_vector_type(4)));
typedef short bf16x8 __attribute__((ext_vector_type(8)));
typedef GAS unsigned gu32;
typedef GAS unsigned long long gu64;
#define RLX_AGENT __ATOMIC_RELAXED, __HIP_MEMORY_SCOPE_AGENT
#define LDS_WAIT() asm volatile("s_waitcnt lgkmcnt(0)" ::: "memory")
#define VM_WAIT() asm volatile("s_waitcnt vmcnt(0)" ::: "memory")
__device__ __forceinline__ unsigned long long rt() { return __builtin_amdgcn_s_memrealtime(); }
__device__ __forceinline__ unsigned f2bf(float f) { unsigned u = __builtin_bit_cast(unsigned, f); return (u + 0x7fffu + ((u >> 16) & 1u)) >> 16; }
__device__ __forceinline__ unsigned pk2(float lo, float hi) { return f2bf(lo) | (f2bf(hi) << 16); }

#define XB_TMO      128
#define XB_XCNT(j)  (256  + 64 * (j))
#define XB_XSUB(j)  (1280 + 64 * (j))
#define XB_XGEN(j)  (2304 + 64 * (j))
#define XB_TOP      3328
#define XB_TOPGEN   3392
#define XCD_BAR_WORDS 3456
#define XB_SPIN_CAP (1u << 18)

__device__ __forceinline__ unsigned xb_ld(unsigned* p)              { return __hip_atomic_load(p, __ATOMIC_RELAXED, __HIP_MEMORY_SCOPE_AGENT); }
__device__ __forceinline__ unsigned xb_add(unsigned* p, unsigned v) { return __hip_atomic_fetch_add(p, v, __ATOMIC_RELAXED, __HIP_MEMORY_SCOPE_AGENT); }
__device__ __forceinline__ unsigned xb_xcc_id() { return (unsigned)__builtin_amdgcn_s_getreg((3 << 11) | 20) & 0xFu; }
#define XB_SPIN(cond, bar) do { unsigned _sp = 0; while (cond) { __builtin_amdgcn_s_sleep(1); \
    if ((++_sp & 255u) == 0u) { if (xb_ld(&(bar)[XB_TMO])) break; if (_sp > XB_SPIN_CAP) { atomicAdd(&(bar)[XB_TMO], 1u); break; } } } } while (0)

struct XcdBarrier {
    unsigned* bar; unsigned x;
    volatile LAS unsigned* st;
};

__device__ __forceinline__ XcdBarrier xcd_barrier_post(unsigned* bar, volatile LAS unsigned* st) {
    XcdBarrier b; b.bar = bar; b.x = xb_xcc_id(); b.st = st;
    if (threadIdx.x == 0) (void)xb_add(&bar[XB_XCNT(b.x)], 1u);
    return b;
}
__device__ __forceinline__ void xcd_barrier_complete(unsigned* bar, unsigned x, unsigned& nloc, unsigned& nx) {
    const unsigned G = gridDim.x * gridDim.y * gridDim.z;
    unsigned sum, cnt, mine, sp = 0u;
    for (;;) {
        sum = 0u; cnt = 0u; mine = 0u;
#pragma unroll
        for (unsigned j = 0; j < 16; ++j) { const unsigned c = xb_ld(&bar[XB_XCNT(j)]); sum += c; cnt += (c > 0u) ? 1u : 0u; mine = (j == x) ? c : mine; }
        if (sum == G) break;
        __builtin_amdgcn_s_sleep(1);
        if ((++sp & 255u) == 0u) { if (xb_ld(&bar[XB_TMO])) break; if (sp > XB_SPIN_CAP) { atomicAdd(&bar[XB_TMO], 1u); break; } }
    }
    nloc = mine > 0u ? mine : 1u; nx = cnt > 0u ? cnt : 1u;
}

__device__ __forceinline__ void xcd_barrier(const XcdBarrier& b) {
    asm volatile("s_waitcnt vmcnt(0)" ::: "memory");
    __syncthreads();
    if (threadIdx.x == 0) {
        unsigned* bar = b.bar;
        __builtin_amdgcn_s_waitcnt(0);
        unsigned nloc = b.st[0], nx = b.st[1];
        if (nloc == 0u) { xcd_barrier_complete(bar, b.x, nloc, nx); b.st[0] = nloc; b.st[1] = nx; }
        const unsigned old = xb_add(&bar[XB_XSUB(b.x)], 1u);
        const unsigned gen = old / nloc;
        if (old + 1u == (gen + 1u) * nloc) {
            __builtin_amdgcn_fence(__ATOMIC_RELEASE, "agent");
            asm volatile("s_waitcnt vmcnt(0)" ::: "memory");
            const unsigned og = xb_add(&bar[XB_TOP], 1u);
            const unsigned tg = og / nx;
            if (og + 1u == (tg + 1u) * nx) xb_add(&bar[XB_TOPGEN], 1u);
            else XB_SPIN(xb_ld(&bar[XB_TOPGEN]) == tg, bar);
            __builtin_amdgcn_fence(__ATOMIC_ACQUIRE, "agent");
            xb_add(&bar[XB_XGEN(b.x)], 1u);
            asm volatile("s_waitcnt vmcnt(0)" ::: "memory");
        } else {
            XB_SPIN(xb_ld(&bar[XB_XGEN(b.x)]) == gen, bar);
            __builtin_amdgcn_fence(__ATOMIC_ACQUIRE, "agent");
            asm volatile("s_waitcnt vmcnt(0)" ::: "memory");
        }
    }
    __syncthreads();
}
__device__ __forceinline__ float wave_sum(float v) {
#pragma unroll
    for (int o = 1; o < 64; o <<= 1) v += __shfl_xor(v, o);
    return v;
}

constexpr int NWAVES = 8;
#ifndef MK_N_LAUNCHES
#define MK_N_LAUNCHES 1
#endif
#ifndef USE_SIMPLE_GEMM
#define USE_SIMPLE_GEMM 0
#endif
constexpr int PER_PHASE = 9;
constexpr int N_LAUNCHES = MK_N_LAUNCHES;

constexpr int BATCH = 16, SEQ = 2048, DM = 1024, M = BATCH * SEQ;
constexpr int NQKV = 4608, NGATE = 2048, N1A = NQKV + NGATE;
constexpr int NFW = 512, NF2 = 1024, FF = 4096, AW = 512;
constexpr int F_OFF = 4608, GA_OFF = 5120, IN_WIDTH = 7168;
constexpr float LN_EPS = 1e-5f, ALPHA = 1.189207115002721f, LOG2E = 1.4426950408889634f, C2 = 0.125f * 1.4426950408889634f;

constexpr size_t MiB = 1u << 20;
constexpr size_t WS_CTL = 0, CTL_ZERO_BYTES = 1 * MiB;
constexpr size_t WS_ETAB = 1 * MiB;
constexpr size_t WS_WIN = 2 * MiB, WS_WF = 15 * MiB, WS_WAO = 17 * MiB, WS_WFO = 18 * MiB, WS_WOUT = 19 * MiB, WS_WUP = 21 * MiB, WS_WDN = 29 * MiB, WS_DFT = 37 * MiB;
constexpr size_t WS_QKV = 56 * MiB, WS_G = 344 * MiB;
constexpr size_t WS_MG = 56 * MiB, WS_Z = 120 * MiB, WS_H1 = 344 * MiB, WS_HB = 56 * MiB, WS_END = 512 * MiB;
constexpr size_t OUT_XB = 0, OUT_UT = 64 * MiB, OUT_ATT = 0, OUT_F = 32 * MiB;
constexpr int CW_TMO = 0, CW_CODE = 1, CW_BAR = 4096;

constexpr int RING_OFF = 0, RING_BYTES = 131072;
constexpr int LDSCTL_OFF = RING_BYTES, MISC_OFF = LDSCTL_OFF + 320;
constexpr int TAB_OFF = RING_BYTES + 1024;
constexpr int LDS_BYTES = 147456;

typedef unsigned v2u __attribute__((ext_vector_type(2)));
typedef float f32x16 __attribute__((ext_vector_type(16)));
__device__ __forceinline__ float bflo(unsigned u) { return __builtin_bit_cast(float, u << 16); }
__device__ __forceinline__ float bfhi(unsigned u) { return __builtin_bit_cast(float, u & 0xffff0000u); }
__device__ __forceinline__ v4u pack8(f32x4 a, f32x4 b) { v4u w; w.x = pg8::cvt_pk_bf16(a[0], a[1]); w.y = pg8::cvt_pk_bf16(a[2], a[3]); w.z = pg8::cvt_pk_bf16(b[0], b[1]); w.w = pg8::cvt_pk_bf16(b[2], b[3]); return w; }
__device__ __forceinline__ void unpack8(v4u w, f32x4& a, f32x4& b) { a = (f32x4){bflo(w.x), bfhi(w.x), bflo(w.y), bfhi(w.y)}; b = (f32x4){bflo(w.z), bfhi(w.z), bflo(w.w), bfhi(w.w)}; }

struct Epi1a {
    static constexpr bool PERM = true; bf16* QKV; bf16* G;
    __device__ __forceinline__ void oct(int row, int col, f32x4 v0, f32x4 v1) const {
        if (col < NQKV) { const float sc = col < 1536 ? C2 : 1.0f; *(v4u*)(QKV + (size_t)row * NQKV + col) = pack8(v0 * sc, v1 * sc); }
        else {
#pragma unroll
            for (int j = 0; j < 4; ++j) { v0[j] = __builtin_amdgcn_rcpf(1.0f + __expf(-v0[j])); v1[j] = __builtin_amdgcn_rcpf(1.0f + __expf(-v1[j])); }
            *(v4u*)(G + (size_t)row * NGATE + (col - NQKV)) = pack8(v0, v1); }
    }
    __device__ __forceinline__ void quad(int row, int col, f32x4 v) const {
        if (col < NQKV) { const float sc = col < 1536 ? C2 : 1.0f; v = v * sc; v2u w; w.x = pg8::cvt_pk_bf16(v[0], v[1]); w.y = pg8::cvt_pk_bf16(v[2], v[3]); *(v2u*)(QKV + (size_t)row * NQKV + col) = w; }
        else {
#pragma unroll
            for (int j = 0; j < 4; ++j) v[j] = __builtin_amdgcn_rcpf(1.0f + __expf(-v[j]));
            v2u w; w.x = pg8::cvt_pk_bf16(v[0], v[1]); w.y = pg8::cvt_pk_bf16(v[2], v[3]); *(v2u*)(G + (size_t)row * NGATE + (col - NQKV)) = w; }
    }
};
struct Epi1b {
    static constexpr bool PERM = true; bf16* UT;
    __device__ __forceinline__ size_t idx(int R, int tok) const { return ((size_t)((tok >> 11) * 512 + (R & 511))) * 4096 + (size_t)((R >> 9) * 2048 + (tok & 2047)); }
    __device__ __forceinline__ void oct(int row, int col, f32x4 v0, f32x4 v1) const { *(v4u*)(UT + idx(row, col)) = pack8(v0, v1); }
    __device__ __forceinline__ void quad(int row, int col, f32x4 v) const { v2u w; w.x = pg8::cvt_pk_bf16(v[0], v[1]); w.y = pg8::cvt_pk_bf16(v[2], v[3]); *(v2u*)(UT + idx(row, col)) = w; }
};
struct EpiF {
    static constexpr bool PERM = true; bf16* Fo;
    __device__ __forceinline__ size_t idx(int k1, int bc) const { return ((size_t)((bc >> 9) * 2048 + k1)) * 512 + (size_t)(bc & 511); }
    __device__ __forceinline__ void oct(int row, int col, f32x4 v0, f32x4 v1) const { *(v4u*)(Fo + idx(row, col)) = pack8(v0, v1); }
    __device__ __forceinline__ void quad(int row, int col, f32x4 v) const { v2u w; w.x = pg8::cvt_pk_bf16(v[0], v[1]); w.y = pg8::cvt_pk_bf16(v[2], v[3]); *(v2u*)(Fo + idx(row, col)) = w; }
};
struct EpiGA {
    static constexpr bool PERM = true; const bf16* G; bf16* MG;
    __device__ __forceinline__ void oct(int row, int col, f32x4 v0, f32x4 v1) const {
        f32x4 g0, g1; unpack8(*(const v4u*)(G + (size_t)row * NGATE + col), g0, g1);
        *(v4u*)(MG + (size_t)row * DM + col) = pack8(g0 * v0, g1 * v1); }
    __device__ __forceinline__ void quad(int row, int col, f32x4 v) const {
        const v2u gw = *(const v2u*)(G + (size_t)row * NGATE + col); const f32x4 g = (f32x4){bflo(gw.x), bfhi(gw.x), bflo(gw.y), bfhi(gw.y)}; v = v * g;
        v2u w; w.x = pg8::cvt_pk_bf16(v[0], v[1]); w.y = pg8::cvt_pk_bf16(v[2], v[3]); *(v2u*)(MG + (size_t)row * DM + col) = w; }
};
struct EpiGB {
    static constexpr bool PERM = true; const bf16* G; bf16* MG;
    __device__ __forceinline__ void oct(int row, int col, f32x4 v0, f32x4 v1) const {
        f32x4 g0, g1, m0, m1; unpack8(*(const v4u*)(G + (size_t)row * NGATE + 1024 + col), g0, g1); unpack8(*(const v4u*)(MG + (size_t)row * DM + col), m0, m1);
        *(v4u*)(MG + (size_t)row * DM + col) = pack8(m0 + g0 * v0, m1 + g1 * v1); }
    __device__ __forceinline__ void quad(int row, int col, f32x4 v) const {
        const v2u gw = *(const v2u*)(G + (size_t)row * NGATE + 1024 + col); const f32x4 g = (f32x4){bflo(gw.x), bfhi(gw.x), bflo(gw.y), bfhi(gw.y)};
        const v2u mw = *(const v2u*)(MG + (size_t)row * DM + col); const f32x4 mm = (f32x4){bflo(mw.x), bfhi(mw.x), bflo(mw.y), bfhi(mw.y)}; v = mm + v * g;
        v2u w; w.x = pg8::cvt_pk_bf16(v[0], v[1]); w.y = pg8::cvt_pk_bf16(v[2], v[3]); *(v2u*)(MG + (size_t)row * DM + col) = w; }
};
struct EpiZ1 {
    static constexpr bool PERM = false; const float* x; float* Z;
    __device__ __forceinline__ void quad(int row, int col, f32x4 v) const { const size_t o = (size_t)row * DM + col; *(f32x4*)(Z + o) = *(const f32x4*)(x + o) * ALPHA + v; }
    __device__ __forceinline__ void oct(int row, int col, f32x4 v0, f32x4 v1) const { quad(row, col, v0); quad(row, col + 4, v1); }
};
struct EpiUp {
    static constexpr bool PERM = true; const float* bias; bf16* HB;
    __device__ __forceinline__ void oct(int row, int col, f32x4 v0, f32x4 v1) const {
        v0 = v0 + *(const f32x4*)(bias + col); v1 = v1 + *(const f32x4*)(bias + col + 4);
#pragma unroll
        for (int j = 0; j < 4; ++j) { const float a = fmaxf(v0[j], 0.f), b = fmaxf(v1[j], 0.f); v0[j] = a * a; v1[j] = b * b; }
        *(v4u*)(HB + (size_t)row * FF + col) = pack8(v0, v1); }
    __device__ __forceinline__ void quad(int row, int col, f32x4 v) const {
        v = v + *(const f32x4*)(bias + col);
#pragma unroll
        for (int j = 0; j < 4; ++j) { const float a = fmaxf(v[j], 0.f); v[j] = a * a; }
        v2u w; w.x = pg8::cvt_pk_bf16(v[0], v[1]); w.y = pg8::cvt_pk_bf16(v[2], v[3]); *(v2u*)(HB + (size_t)row * FF + col) = w; }
};
struct EpiZ2 {
    static constexpr bool PERM = false; const bf16* H1; const float* bias; float* Z;
    __device__ __forceinline__ void quad(int row, int col, f32x4 v) const { const size_t o = (size_t)row * DM + col;
        const v2u hw = *(const v2u*)(H1 + o); const f32x4 h = (f32x4){bflo(hw.x), bfhi(hw.x), bflo(hw.y), bfhi(hw.y)};
        *(f32x4*)(Z + o) = h * ALPHA + v + *(const f32x4*)(bias + col); }
    __device__ __forceinline__ void oct(int row, int col, f32x4 v0, f32x4 v1) const { quad(row, col, v0); quad(row, col + 4, v1); }
};

struct Frame {
    LAS unsigned char* lds;
    volatile LAS unsigned* MISC;
    gu32* ctl;
    int tid, lane, wave;
    int vcu, G;
    const float *x, *rel_bias, *w_in, *w_fo, *w_ao, *w_out, *ln1_g, *ln1_b, *w_up, *b_up, *w_down, *b_down, *ln2_g, *ln2_b;
    float* out;
    float* Etab;
    bf16 *WinT, *WfT, *WaoT, *WfoT, *WoutT, *WupT, *WdnT, *DFT;
    bf16 *XB, *UT, *ATT, *FB, *QKV, *GB, *MG, *H1, *HB;
    float* Z;
};

template <class Epi>
__device__ __forceinline__ void gemm_simple_phase(const pg8::Gemm g, const Epi& E, int gw, int ngw, int lane) {
    const int tn = g.N / 64, nt = (g.M / 64) * tn, r = lane & 31, h = lane >> 5;
    for (int t = gw; t < nt; t += ngw) {
        const int pm = t / tn, pn = t % tn;
        f32x16 acc[2][2];
#pragma unroll
        for (int a = 0; a < 2; ++a)
#pragma unroll
            for (int b = 0; b < 2; ++b)
#pragma unroll
                for (int i = 0; i < 16; ++i) acc[a][b][i] = 0.f;
        const bf16* Ap = g.A + (size_t)(pm * 64 + r) * g.K + 8 * h;
        const bf16* Bp = g.Bt + (size_t)(pn * 64 + r) * g.K + 8 * h;
        for (int k = 0; k < g.K; k += 16) {
            const bf16x8 a0 = *(const bf16x8*)(Ap + k), a1 = *(const bf16x8*)(Ap + (size_t)32 * g.K + k);
            const bf16x8 b0 = *(const bf16x8*)(Bp + k), b1 = *(const bf16x8*)(Bp + (size_t)32 * g.K + k);
            acc[0][0] = __builtin_amdgcn_mfma_f32_32x32x16_bf16(b0, a0, acc[0][0], 0, 0, 0);
            acc[0][1] = __builtin_amdgcn_mfma_f32_32x32x16_bf16(b1, a0, acc[0][1], 0, 0, 0);
            acc[1][0] = __builtin_amdgcn_mfma_f32_32x32x16_bf16(b0, a1, acc[1][0], 0, 0, 0);
            acc[1][1] = __builtin_amdgcn_mfma_f32_32x32x16_bf16(b1, a1, acc[1][1], 0, 0, 0);
        }
#pragma unroll
        for (int ri = 0; ri < 2; ++ri)
#pragma unroll
            for (int ci = 0; ci < 2; ++ci)
#pragma unroll
                for (int q4 = 0; q4 < 4; ++q4)
                    E.quad(pm * 64 + 32 * ri + r, pn * 64 + 32 * ci + 8 * q4 + 4 * h, (f32x4){acc[ri][ci][4 * q4], acc[ri][ci][4 * q4 + 1], acc[ri][ci][4 * q4 + 2], acc[ri][ci][4 * q4 + 3]});
    }
}

template <class EF, bool ALIGN>
__device__ __forceinline__ void run_gemm(Frame& F, const bf16* A, const bf16* Bt, int Mm, int Nn, int Kk, const EF& ef) {
    pg8::Gemm g{A, Bt, Mm, Nn, Kk};
#if USE_SIMPLE_GEMM
    gemm_simple_phase<EF>(g, ef, F.vcu * NWAVES + F.wave, F.G * NWAVES, F.lane);
#else
    pg8::StaticOrder S; S.init(Mm, Nn, F.G, (int)blockIdx.x);
    pg8::EpiAdapt<EF> E{ef};
    pg8::gemm_phase<pg8::EpiAdapt<EF>, pg8::StaticOrder, ALIGN, true>(F.lds + RING_OFF, g, S, E);
#endif
}

__device__ __forceinline__ void p0_transpose_item(const float* W, int ld, int K, int ncols, bf16* WT, int row_off, LAS float* scr, int item, int lane) {
    const int nblk = ncols / 32, kb = item / nblk, nb = item % nblk, k0 = 64 * kb, n0 = 32 * nb;
#pragma unroll 8
    for (int i = 0; i < 32; ++i) { const int kk = 2 * i + (lane >> 5); scr[kk * 33 + (lane & 31)] = W[(size_t)(k0 + kk) * ld + n0 + (lane & 31)]; }
    LDS_WAIT(); asm volatile("" ::: "memory");
    const int c = lane & 7;
#pragma unroll
    for (int j = 0; j < 4; ++j) { const int n = (lane >> 3) + 8 * j; const LAS float* s = scr + (8 * c) * 33 + n;
        v4u o; o.x = pk2(s[0 * 33], s[1 * 33]); o.y = pk2(s[2 * 33], s[3 * 33]); o.z = pk2(s[4 * 33], s[5 * 33]); o.w = pk2(s[6 * 33], s[7 * 33]);
        *(GAS v4u*)(WT + (size_t)(row_off + n0 + n) * K + k0 + 8 * c) = o; }
    LDS_WAIT(); asm volatile("" ::: "memory");
}
__device__ __forceinline__ void p0_fold_item(const float* w_in, bf16* WfT, LAS float* scr, int item, int lane) {
    const int half = item & 1, kb = (item >> 1) & 63, g = item >> 7, k0 = 16 * kb;
    LAS float* tw = scr + 16 * 129;
#pragma unroll
    for (int i = 0; i < 2; ++i) { const int j = lane + 64 * i; tw[j] = (half ? sinpif((float)j * (1.0f / 64.0f)) : cospif((float)j * (1.0f / 64.0f))) * 0.08838834764831845f; }
#pragma unroll 8
    for (int i = 0; i < 32; ++i) { const int kk = i >> 1, n2 = (i & 1) * 64 + lane; scr[kk * 129 + n2] = w_in[(size_t)(k0 + kk) * IN_WIDTH + F_OFF + g * 128 + n2]; }
    LDS_WAIT(); asm volatile("" ::: "memory");
    const int kk = lane & 15, sub = lane >> 4;
    for (int j = 0; j < 32; ++j) { const int k2 = sub * 32 + j; float s = 0.f;
#pragma unroll 16
        for (int n2 = 0; n2 < 128; ++n2) s += scr[kk * 129 + n2] * tw[(k2 * n2) & 127];
        WfT[(size_t)(half * 512 + g * 128 + k2) * DM + k0 + kk] = (bf16)f2bf(s); }
    LDS_WAIT(); asm volatile("" ::: "memory");
}
__device__ __forceinline__ int t5_bucket(int rel) {
    const int n = rel < 0 ? -rel : rel; int bk;
    if (n < 8) bk = n; else { bk = 8 + (int)(logf((float)n * 0.125f) / 4.852030263919617f * 8.0f); bk = bk < 15 ? bk : 15; }
    return bk + (rel > 0 ? 16 : 0);
}
__device__ __forceinline__ void p0_prologue(Frame& F) {
    LAS float* scr = (LAS float*)(F.lds + RING_OFF + F.wave * 16384);
    LAS float* ct = (LAS float*)(F.lds + TAB_OFF);
    for (int m = F.tid; m < 2048; m += NWAVES * 64) ct[m] = cospif((float)m * (1.0f / 1024.0f)) * 0.022097086912079608f;
    __syncthreads();
    const int gw = F.vcu * NWAVES + F.wave, NGW = F.G * NWAVES;
    for (int k1 = gw; k1 < SEQ; k1 += NGW) {
#pragma unroll
        for (int j = 0; j < 8; ++j) { const int c8 = (F.lane + 64 * j) * 8, part = c8 >> 11, n1 = c8 & 2047; float v[8];
#pragma unroll
            for (int e = 0; e < 8; ++e) { const int mm = k1 * (n1 + e); v[e] = part ? -ct[(mm - 512) & 2047] : ct[mm & 2047]; }
            v4u o; o.x = pk2(v[0], v[1]); o.y = pk2(v[2], v[3]); o.z = pk2(v[4], v[5]); o.w = pk2(v[6], v[7]);
            *(GAS v4u*)(F.DFT + (size_t)k1 * 4096 + c8) = o; }
    }
    for (int hh = gw; hh < 24; hh += NGW) { const int d = hh < 8 ? 1 : (hh < 16 ? 4 : 16);
#pragma unroll
        for (int i = 0; i < 4; ++i) { const int e = F.lane + 64 * i, rel = e - 128;
            F.Etab[hh * 256 + e] = (rel >= -64 && rel <= 64) ? F.rel_bias[t5_bucket(rel * d) * 24 + hh] * LOG2E : -1.0e30f; } }
    constexpr int I_IN1 = (DM / 64) * (NQKV / 32), I_IN2 = (DM / 64) * (NGATE / 32), I_AO = (AW / 64) * (DM / 32), I_FO = (NFW / 64) * (DM / 32), I_OUT = (DM / 64) * (DM / 32),
                  I_UP = (DM / 64) * (FF / 32), I_DN = (FF / 64) * (DM / 32), I_FOLD = 512;
    constexpr int NITEMS = I_IN1 + I_IN2 + I_AO + I_FO + I_OUT + I_UP + I_DN + I_FOLD;
    for (int it = gw; it < NITEMS; it += NGW) {
        int r = it;
        if (r < I_FOLD) { p0_fold_item(F.w_in, F.WfT, scr, r, F.lane); continue; } r -= I_FOLD;
        if (r < I_IN1) { p0_transpose_item(F.w_in, IN_WIDTH, DM, NQKV, F.WinT, 0, scr, r, F.lane); continue; } r -= I_IN1;
        if (r < I_IN2) { p0_transpose_item(F.w_in + GA_OFF, IN_WIDTH, DM, NGATE, F.WinT, NQKV, scr, r, F.lane); continue; } r -= I_IN2;
        if (r < I_AO) { p0_transpose_item(F.w_ao, DM, AW, DM, F.WaoT, 0, scr, r, F.lane); continue; } r -= I_AO;
        if (r < I_FO) { p0_transpose_item(F.w_fo, DM, NFW, DM, F.WfoT, 0, scr, r, F.lane); continue; } r -= I_FO;
        if (r < I_OUT) { p0_transpose_item(F.w_out, DM, DM, DM, F.WoutT, 0, scr, r, F.lane); continue; } r -= I_OUT;
        if (r < I_UP) { p0_transpose_item(F.w_up, FF, DM, FF, F.WupT, 0, scr, r, F.lane); continue; } r -= I_UP;
        p0_transpose_item(F.w_down, DM, FF, DM, F.WdnT, 0, scr, r, F.lane);
    }
    for (size_t i8 = (size_t)gw * 64 + F.lane; i8 < (size_t)M * DM / 8; i8 += (size_t)NGW * 64) {
        const f32x4 a = *(const GAS f32x4*)(F.x + i8 * 8), b = *(const GAS f32x4*)(F.x + i8 * 8 + 4);
        v4u o; o.x = pk2(a[0], a[1]); o.y = pk2(a[2], a[3]); o.z = pk2(b[0], b[1]); o.w = pk2(b[2], b[3]);
        *(GAS v4u*)(F.XB + i8 * 8) = o; }
}

__device__ __forceinline__ void attn_simple_phase(Frame& F) {
    for (int i = F.vcu * (NWAVES * 64) + F.tid; i < M * 8; i += F.G * NWAVES * 64) {
        const int hg = i >> 15, token = i & (M - 1), b = token >> 11, tt = token & 2047;
        float acc[64];
#pragma unroll
        for (int j = 0; j < 64; ++j) acc[j] = 0.f;
        float mrun = -3.0e38f, l = 0.f;
        for (int g = 0; g < 3; ++g) {
            const int hh = g * 8 + hg, sh = 2 * g, L = SEQ >> sh, r = tt & ((1 << sh) - 1), n = tt >> sh;
            float q[64];
            { const v4u* qp = (const v4u*)(F.QKV + (size_t)token * NQKV + hh * 64);
#pragma unroll
              for (int c = 0; c < 8; ++c) { const v4u w = qp[c]; q[8 * c] = bflo(w.x); q[8 * c + 1] = bfhi(w.x); q[8 * c + 2] = bflo(w.y); q[8 * c + 3] = bfhi(w.y); q[8 * c + 4] = bflo(w.z); q[8 * c + 5] = bfhi(w.z); q[8 * c + 6] = bflo(w.w); q[8 * c + 7] = bfhi(w.w); } }
            const float* et = F.Etab + hh * 256 + 128;
            const int mlo = -64 > -n ? -64 : -n, mhi = 64 < (L - 1 - n) ? 64 : (L - 1 - n);
            for (int m = mlo; m <= mhi; ++m) {
                const bf16* kr = F.QKV + (size_t)(b * SEQ + ((n + m) << sh) + r) * NQKV + 1536 + hh * 64;
                float s = 0.f;
#pragma unroll
                for (int c = 0; c < 8; ++c) { const v4u w = ((const v4u*)kr)[c];
                    s += q[8 * c] * bflo(w.x) + q[8 * c + 1] * bfhi(w.x) + q[8 * c + 2] * bflo(w.y) + q[8 * c + 3] * bfhi(w.y) + q[8 * c + 4] * bflo(w.z) + q[8 * c + 5] * bfhi(w.z) + q[8 * c + 6] * bflo(w.w) + q[8 * c + 7] * bfhi(w.w); }
                s += et[m];
                if (s > mrun) { const float corr = exp2f(mrun - s); l *= corr;
#pragma unroll
                    for (int j = 0; j < 64; ++j) acc[j] *= corr;
                    mrun = s; }
                const float p = exp2f(s - mrun); l += p;
                const bf16* vr = kr + 1536;
#pragma unroll
                for (int c = 0; c < 8; ++c) { const v4u w = ((const v4u*)vr)[c];
                    acc[8 * c] += p * bflo(w.x); acc[8 * c + 1] += p * bfhi(w.x); acc[8 * c + 2] += p * bflo(w.y); acc[8 * c + 3] += p * bfhi(w.y);
                    acc[8 * c + 4] += p * bflo(w.z); acc[8 * c + 5] += p * bfhi(w.z); acc[8 * c + 6] += p * bflo(w.w); acc[8 * c + 7] += p * bfhi(w.w); }
            }
        }
        const float inv = 1.0f / l;
        v4u* op = (v4u*)(F.ATT + (size_t)token * AW + hg * 64);
#pragma unroll
        for (int c = 0; c < 8; ++c) { v4u o; o.x = pk2(acc[8 * c] * inv, acc[8 * c + 1] * inv); o.y = pk2(acc[8 * c + 2] * inv, acc[8 * c + 3] * inv); o.z = pk2(acc[8 * c + 4] * inv, acc[8 * c + 5] * inv); o.w = pk2(acc[8 * c + 6] * inv, acc[8 * c + 7] * inv); op[c] = o; }
    }
}

template <bool TO_BF16>
__device__ __forceinline__ void ln_rows_phase(Frame& F, const float* Z, const float* gam, const float* bet, bf16* ob, float* of) {
    const int gw = F.vcu * NWAVES + F.wave, NGW = F.G * NWAVES;
    f32x4 gv[4], bv[4];
#pragma unroll
    for (int j = 0; j < 4; ++j) { gv[j] = *(const GAS f32x4*)(gam + (F.lane + 64 * j) * 4); bv[j] = *(const GAS f32x4*)(bet + (F.lane + 64 * j) * 4); }
    for (int m = gw; m < M; m += NGW) {
        const GAS f32x4* xr = (const GAS f32x4*)(Z + (size_t)m * DM) + F.lane;
        f32x4 v[4]; float s = 0.f;
#pragma unroll
        for (int j = 0; j < 4; ++j) { v[j] = xr[64 * j]; s += (v[j].x + v[j].y) + (v[j].z + v[j].w); }
        const float mean = wave_sum(s) * (1.f / DM); float s2 = 0.f;
#pragma unroll
        for (int j = 0; j < 4; ++j) { v[j] = v[j] - mean; s2 += (v[j].x * v[j].x + v[j].y * v[j].y) + (v[j].z * v[j].z + v[j].w * v[j].w); }
        const float rstd = 1.f / sqrtf(wave_sum(s2) * (1.f / DM) + LN_EPS);
#pragma unroll
        for (int j = 0; j < 4; ++j) { const f32x4 o = v[j] * rstd * gv[j] + bv[j];
            if (TO_BF16) { v2u w; w.x = pk2(o[0], o[1]); w.y = pk2(o[2], o[3]); *((GAS v2u*)(ob + (size_t)m * DM) + F.lane + 64 * j) = w; }
            else *((GAS f32x4*)(of + (size_t)m * DM) + F.lane + 64 * j) = o; }
    }
}


__device__ __forceinline__ void probe_bf16(Frame& F, const bf16* src, size_t n) {
    for (size_t i = (size_t)F.vcu * (NWAVES * 64) + F.tid; i < (size_t)M * DM; i += (size_t)F.G * NWAVES * 64) F.out[i] = bflo((unsigned)src[i % n]);
}
struct Args { const float* in[14]; float* out; unsigned char* ws; int ph_lo, ph_hi, li, pad; };
__global__ void __launch_bounds__(NWAVES * 64, 2) fwd_kernel(Args args) {
    extern __shared__ __attribute__((aligned(16))) unsigned char lds[];
    Frame F;
    F.lds = (LAS unsigned char*)lds;
    F.MISC = (volatile LAS unsigned*)(F.lds + MISC_OFF);
    F.tid = threadIdx.x; F.lane = F.tid & 63; F.wave = __builtin_amdgcn_readfirstlane(F.tid >> 6);
    F.G = gridDim.x; { const int bx = blockIdx.x; F.vcu = (F.G % 8 == 0) ? (bx % 8) * (F.G / 8) + bx / 8 : bx; }
#define GRID_BAR(seam) do { if (N_LAUNCHES == PER_PHASE) { if (F.tid == 0) __hip_atomic_store(F.ctl + CW_TMO, 0xBADBA0u | (unsigned)(seam), RLX_AGENT); } \
    else { xcd_barrier(bar); } } while (0)
    unsigned char* ws = args.ws; unsigned char* ob = (unsigned char*)args.out;
    F.ctl = (gu32*)(ws + WS_CTL);
    F.x = args.in[0]; F.rel_bias = args.in[1]; F.w_in = args.in[2]; F.w_fo = args.in[3]; F.w_ao = args.in[4]; F.w_out = args.in[5]; F.ln1_g = args.in[6]; F.ln1_b = args.in[7];
    F.w_up = args.in[8]; F.b_up = args.in[9]; F.w_down = args.in[10]; F.b_down = args.in[11]; F.ln2_g = args.in[12]; F.ln2_b = args.in[13]; F.out = args.out;
    F.Etab = (float*)(ws + WS_ETAB);
    F.WinT = (bf16*)(ws + WS_WIN); F.WfT = (bf16*)(ws + WS_WF); F.WaoT = (bf16*)(ws + WS_WAO); F.WfoT = (bf16*)(ws + WS_WFO); F.WoutT = (bf16*)(ws + WS_WOUT);
    F.WupT = (bf16*)(ws + WS_WUP); F.WdnT = (bf16*)(ws + WS_WDN); F.DFT = (bf16*)(ws + WS_DFT);
    F.XB = (bf16*)(ob + OUT_XB); F.UT = (bf16*)(ob + OUT_UT); F.ATT = (bf16*)(ob + OUT_ATT); F.FB = (bf16*)(ob + OUT_F);
    F.QKV = (bf16*)(ws + WS_QKV); F.GB = (bf16*)(ws + WS_G); F.MG = (bf16*)(ws + WS_MG); F.H1 = (bf16*)(ws + WS_H1); F.HB = (bf16*)(ws + WS_HB); F.Z = (float*)(ws + WS_Z);
    for (int u = F.tid; u < (LDS_BYTES - LDSCTL_OFF) / 4; u += NWAVES * 64) ((LAS unsigned*)(F.lds + LDSCTL_OFF))[u] = 0u;
    __syncthreads();
    const int bli = (N_LAUNCHES == PER_PHASE) ? 0 : args.li;
    XcdBarrier bar; bar.bar = (unsigned*)(F.ctl + CW_BAR) + bli * XCD_BAR_WORDS; bar.x = 0; bar.st = nullptr;
    if (N_LAUNCHES != PER_PHASE) bar = xcd_barrier_post((unsigned*)(F.ctl + CW_BAR) + bli * XCD_BAR_WORDS, F.MISC + 8);
    const int lo = args.ph_lo, hi = args.ph_hi;
#ifdef PROBE_LAST
#define IN(k) (lo <= (k) && (k) < hi && (k) <= PROBE_LAST)
    {
        bf16* tmp = (bf16*)(ws + 472 * MiB);
        if (lo <= PROBE_LAST + 1 && PROBE_LAST + 1 < hi) { const bf16* src = PROBE_PTR; for (size_t i = (size_t)F.vcu * (NWAVES * 64) + F.tid; i < (size_t)(PROBE_N); i += (size_t)F.G * NWAVES * 64) tmp[i] = src[(size_t)(PROBE_OFF) + i]; }
        if (lo <= PROBE_LAST + 2 && PROBE_LAST + 2 < hi) probe_bf16(F, tmp, (size_t)(PROBE_N));
    }
#else
#define IN(k) (lo <= (k) && (k) < hi)
#endif
#define BOTH(k) (IN(k) && IN((k) + 1))

    if (IN(0)) { p0_prologue(F); if (BOTH(0)) GRID_BAR(0); }
    if (IN(1)) {
        { Epi1a e{F.QKV, F.GB}; run_gemm<Epi1a, true>(F, F.XB, F.WinT, M, N1A, DM, e); }
        { Epi1b e{F.UT}; run_gemm<Epi1b, true>(F, F.WfT, F.XB, NF2, M, DM, e); }
        if (BOTH(1)) GRID_BAR(1);
    }
    if (IN(2)) {
        attn_simple_phase(F);
        __syncthreads();
        { EpiF e{F.FB}; run_gemm<EpiF, true>(F, F.DFT, F.UT, SEQ, BATCH * NFW, 2 * SEQ, e); }
        if (BOTH(2)) GRID_BAR(2);
    }
    if (IN(3)) {
        { EpiGA e{F.GB, F.MG}; run_gemm<EpiGA, true>(F, F.ATT, F.WaoT, M, DM, AW, e); }
        VM_WAIT(); __syncthreads();
        { EpiGB e{F.GB, F.MG}; run_gemm<EpiGB, true>(F, F.FB, F.WfoT, M, DM, NFW, e); }
        if (BOTH(3)) GRID_BAR(3);
    }
    if (IN(4)) {
        { EpiZ1 e{F.x, F.Z}; run_gemm<EpiZ1, true>(F, F.MG, F.WoutT, M, DM, DM, e); }
        if (BOTH(4)) GRID_BAR(4);
    }
    if (IN(5)) { ln_rows_phase<true>(F, F.Z, F.ln1_g, F.ln1_b, F.H1, nullptr); if (BOTH(5)) GRID_BAR(5); }
    if (IN(6)) {
        { EpiUp e{F.b_up, F.HB}; run_gemm<EpiUp, true>(F, F.H1, F.WupT, M, FF, DM, e); }
        if (BOTH(6)) GRID_BAR(6);
    }
    if (IN(7)) {
        { EpiZ2 e{F.H1, F.b_down, F.out}; run_gemm<EpiZ2, true>(F, F.HB, F.WdnT, M, DM, FF, e); }
        if (BOTH(7)) GRID_BAR(7);
    }
    if (IN(8)) { ln_rows_phase<false>(F, F.out, F.ln2_g, F.ln2_b, nullptr, F.out); }
#undef IN
#undef BOTH
}

extern "C" void kernel_launch(void* const* d_in, const int* in_sizes, int n_in, void* d_out, int out_size, void* d_ws, size_t ws_size, hipStream_t stream) {
    static int grid = 0;
    if (grid == 0) {
        if (n_in != 14 || in_sizes[0] != M * DM || out_size != M * DM || ws_size < WS_END) { fprintf(stderr, "kernel_launch: unexpected shapes / workspace (n_in %d, in0 %d, out %d, ws %zu); nothing launched\n", n_in, n_in > 0 ? in_sizes[0] : -1, out_size, ws_size); grid = -1; return; }
        int dev = 0, cus = 0, per_cu = 0;
        if (hipGetDevice(&dev) != hipSuccess || hipDeviceGetAttribute(&cus, hipDeviceAttributeMultiprocessorCount, dev) != hipSuccess) { grid = -1; return; }
        if (hipFuncSetAttribute((const void*)fwd_kernel, hipFuncAttributeMaxDynamicSharedMemorySize, LDS_BYTES) != hipSuccess) { fprintf(stderr, "kernel_launch: hipFuncSetAttribute failed\n"); grid = -1; return; }
        if (hipOccupancyMaxActiveBlocksPerMultiprocessor(&per_cu, (const void*)fwd_kernel, NWAVES * 64, LDS_BYTES) != hipSuccess || per_cu < 1)
            fprintf(stderr, "kernel_launch: note: occupancy query reports %d workgroups per CU\n", per_cu);
        (void)hipGetLastError();
        grid = cus;
    }
    if (grid < 0) return;
    if (hipMemsetAsync((char*)d_ws + WS_CTL, 0, CTL_ZERO_BYTES, stream) != hipSuccess) { fprintf(stderr, "kernel_launch: hipMemsetAsync failed\n"); return; }
    Args a{};
    for (int i = 0; i < 14; ++i) a.in[i] = (const float*)d_in[i];
    a.out = (float*)d_out; a.ws = (unsigned char*)d_ws;
    for (int li = 0; li < N_LAUNCHES; ++li) {
        a.ph_lo = (N_LAUNCHES == PER_PHASE) ? li : 0; a.ph_hi = (N_LAUNCHES == PER_PHASE) ? li + 1 : PER_PHASE; a.li = (N_LAUNCHES == PER_PHASE) ? 0 : li;
        hipLaunchKernelGGL(fwd_kernel, dim3(grid), dim3(NWAVES * 64), LDS_BYTES, stream, a);
        const hipError_t le = hipPeekAtLastError();
        if (le != hipSuccess) { fprintf(stderr, "kernel_launch: launch %d failed: %s\n", li, hipGetErrorName(le)); break; }
    }
}
```

```cpp
#include <hip/hip_runtime.h>
#include <cstdio>
#include <cstdint>
#define MK_N_LAUNCHES 1
namespace pg8 {
#define PG8_LAS __attribute__((address_space(3)))
typedef unsigned short bf16_t;
typedef short bf16x8 __attribute__((ext_vector_type(8)));
typedef float f32x4 __attribute__((ext_vector_type(4)));
typedef unsigned u32x4 __attribute__((ext_vector_type(4)));
constexpr int BM = 256, BK = 64, HALF = 128, HTB = HALF * BK * 2  , STAGE_BYTES = 8 * HTB, NXCD = 8, WGM = 8;

__host__ __device__ __forceinline__ int lds_byte(int r, int c) { const int st = (r >> 4) * 2 + (c >> 5), rr = r & 15, cc = c & 31, ob = rr * 64 + cc * 2; return st * 1024 + (ob ^ (((ob >> 9) & 1) << 5)); }
__host__ __device__ __forceinline__ void stage_rc(int b, int& R, int& C) { const int st = b / 1024, sb = b % 1024, swz = sb ^ (((sb >> 9) & 1) << 5); R = (st >> 1) * 16 + swz / 64; C = (st & 1) * 32 + (swz % 64) / 2; }
__host__ __device__ __forceinline__ int perm32(int rho) { const int n = rho >> 4, i = rho & 15; return 8 * (i >> 2) + 4 * n + (i & 3); }

struct Unit { int pm, pn; };
struct Gemm { const bf16_t* A; const bf16_t* Bt; int M, N, K; };

struct StaticOrder {
    int nM, nN, nwg, G, c;
    __host__ __device__ void init(int M, int N, int G_, int c_) { nM = M / BM; nN = N / BM; nwg = nM * nN; G = G_; c = c_; }
    __host__ __device__ bool next(int i, Unit& u) const {
        const long L = (long)i * G + c; if (L >= nwg) return false;
        int wgid = (int)L; { const int q = nwg / NXCD, r = nwg % NXCD, xcd = wgid % NXCD, off = wgid / NXCD; wgid = (xcd < r ? xcd * (q + 1) : r * (q + 1) + (xcd - r) * q) + off; }
        const int nig = WGM * nN, gid = wgid / nig, fm = gid * WGM, gsz = (nM - fm) < WGM ? (nM - fm) : WGM;
        u.pm = fm + ((wgid % nig) % gsz); u.pn = (wgid % nig) / gsz; return true;
    }
    __device__ __forceinline__ void a_ready(const Unit&) const {}
    __device__ __forceinline__ void done(const Unit&) const {}
};
typedef float f32x2 __attribute__((ext_vector_type(2)));
typedef __bf16 bf16x2_t __attribute__((ext_vector_type(2)));
__device__ __forceinline__ unsigned cvt_pk_bf16(float lo, float hi) { f32x2 v = {lo, hi}; bf16x2_t b = __builtin_convertvector(v, bf16x2_t); return __builtin_bit_cast(unsigned, b); }
template <class F> struct EpiAdapt {
    static constexpr bool PERM = F::PERM, AFTER_DRAIN = false; F f;
    __device__ __forceinline__ void operator()(const f32x4 (&acc)[2][2][4][2], const Unit& u, int wr, int wc, int fr, int fq) const {
        const int row0 = u.pm * BM + wr * 64 + fr;
        if constexpr (F::PERM) {
            const int col0 = u.pn * BM + wc * 32 + 8 * fq;
#pragma unroll
            for (int ai = 0; ai < 2; ++ai)
#pragma unroll
                for (int m = 0; m < 4; ++m)
#pragma unroll
                    for (int bj = 0; bj < 2; ++bj) f.oct(row0 + ai * HALF + m * 16, col0 + bj * HALF, acc[ai][bj][m][0], acc[ai][bj][m][1]);
        } else {
            const int col0 = u.pn * BM + wc * 32 + 4 * fq;
#pragma unroll
            for (int ai = 0; ai < 2; ++ai)
#pragma unroll
                for (int m = 0; m < 4; ++m)
#pragma unroll
                    for (int bj = 0; bj < 2; ++bj)
#pragma unroll
                        for (int n = 0; n < 2; ++n) f.quad(row0 + ai * HALF + m * 16, col0 + bj * HALF + n * 16, acc[ai][bj][m][n]);
        }
    }
};
template <class Epi, class Sched, bool ALIGN_EPI = false, bool SP2 = false>
__device__ __forceinline__ void gemm_phase(PG8_LAS unsigned char* lds, const Gemm g, const Sched& S, const Epi& E) {
    const int tid = threadIdx.x, wid = __builtin_amdgcn_readfirstlane(tid >> 6), lane = tid & 63, wr = wid >> 2, wc = wid & 3, fr = lane & 15, fq = lane >> 4;
    const int K = g.K, nt = K / BK;
    unsigned voffA[2], voffB[2];
#pragma unroll
    for (int i = 0; i < 2; ++i) { int R, C; stage_rc(tid * 16 + i * 8192, R, C); const int Rb = Epi::PERM ? ((R & ~31) + perm32(R & 31)) : R;
        voffA[i] = (unsigned)(R * K + C) * 2u; voffB[i] = (unsigned)(Rb * K + C) * 2u; }
    const size_t kstep = (size_t)(BK * 2);
    const size_t hstep = (size_t)HALF * K * 2;
    const size_t tstep = 2 * hstep;
    const unsigned ldsw = (unsigned)wid * 1024u;
    const int aoff = lds_byte(wr * 64 + fr, fq * 8), boff = lds_byte(wc * 32 + fr, fq * 8);
#define PG8_SA(b, h) (((b) * 2 + (h)) * HTB)
#define PG8_SB(b, h) ((4 + (b) * 2 + (h)) * HTB)
#define PG8_STAGE(bufoff, gbase, voff) do { _Pragma("unroll") for (int _i = 0; _i < 2; ++_i) \
        __builtin_amdgcn_global_load_lds((const unsigned*)((const char*)(gbase) + (voff)[_i]), (PG8_LAS unsigned*)(lds + (bufoff) + ldsw + _i * 8192), 16, 0, 0); } while (0)
#define PG8_LDA(dst, b, h) do { _Pragma("unroll") for (int m = 0; m < 4; ++m) _Pragma("unroll") for (int k = 0; k < 2; ++k) dst[m][k] = *(const PG8_LAS bf16x8*)(lds + PG8_SA(b, h) + aoff + m * 2048 + k * 1024); } while (0)
#define PG8_LDB(dst, b, h) do { _Pragma("unroll") for (int n = 0; n < 2; ++n) _Pragma("unroll") for (int k = 0; k < 2; ++k) dst[n][k] = *(const PG8_LAS bf16x8*)(lds + PG8_SB(b, h) + boff + n * 2048 + k * 1024); } while (0)
#define PG8_MMA(ai, bj, At, Bt) do { __builtin_amdgcn_s_setprio(1); _Pragma("unroll") for (int m = 0; m < 4; ++m) _Pragma("unroll") for (int n = 0; n < 2; ++n) _Pragma("unroll") for (int k = 0; k < 2; ++k) \
        acc[ai][bj][m][n] = __builtin_amdgcn_mfma_f32_16x16x32_bf16(Bt[n][k], At[m][k], acc[ai][bj][m][n], 0, 0, 0); __builtin_amdgcn_s_setprio(0); } while (0)
#define PG8_WAIT_V(n) asm volatile("s_waitcnt vmcnt(" #n ")" ::: "memory")
#define PG8_WAIT_L(n) asm volatile("s_waitcnt lgkmcnt(" #n ")" ::: "memory")
#define PG8_BAR __builtin_amdgcn_s_barrier()
#define PG8_SCHED __builtin_amdgcn_sched_barrier(0)
    Unit cur, nxt; int ui = 0;
    if (!S.next(0, cur)) return;
    f32x4 acc[2][2][4][2];
#pragma unroll
    for (int a = 0; a < 2; ++a)
#pragma unroll
        for (int b = 0; b < 2; ++b)
#pragma unroll
            for (int m = 0; m < 4; ++m)
#pragma unroll
                for (int n = 0; n < 2; ++n) acc[a][b][m][n] = (f32x4){0.f, 0.f, 0.f, 0.f};
    bf16x8 At[4][2], B0[2][2], B1[2][2];
    const char* cA = (const char*)g.A + (size_t)cur.pm * tstep; const char* cB = (const char*)g.Bt + (size_t)cur.pn * tstep;
    S.a_ready(cur);
    if constexpr (SP2) {
        PG8_STAGE(PG8_SB(0, 0), cB, voffB); PG8_STAGE(PG8_SB(0, 1), cB + hstep, voffB); PG8_STAGE(PG8_SA(0, 0), cA, voffA); PG8_STAGE(PG8_SA(0, 1), cA + hstep, voffA);
        if (wr == 1) PG8_BAR;
        PG8_WAIT_V(2); PG8_BAR;
        PG8_STAGE(PG8_SB(1, 0), cB + kstep, voffB); PG8_STAGE(PG8_SA(1, 0), cA + kstep, voffA); PG8_STAGE(PG8_SB(1, 1), cB + hstep + kstep, voffB);
        PG8_WAIT_V(6); PG8_BAR;
    } else {
        PG8_STAGE(PG8_SB(0, 0), cB, voffB); PG8_STAGE(PG8_SA(0, 0), cA, voffA); PG8_STAGE(PG8_SB(0, 1), cB + hstep, voffB); PG8_STAGE(PG8_SA(0, 1), cA + hstep, voffA);
        if (wr == 1) PG8_BAR;
        PG8_WAIT_V(4); PG8_BAR;
        PG8_STAGE(PG8_SB(1, 0), cB + kstep, voffB); PG8_STAGE(PG8_SA(1, 0), cA + kstep, voffA); PG8_STAGE(PG8_SB(1, 1), cB + hstep + kstep, voffB);
        PG8_WAIT_V(6); PG8_BAR;
    }
    for (;;) {
        const bool has_next = S.next(ui + 1, nxt);
        const char* nA = has_next ? (const char*)g.A + (size_t)nxt.pm * tstep : cA; const char* nB = has_next ? (const char*)g.Bt + (size_t)nxt.pn * tstep : cB;
        for (int t = 0; t < nt; t += 2) {
            const bool last = (t == nt - 2);
            const char* a1 = cA + (size_t)(t + 1) * kstep;
            const char* a2 = last ? nA : cA + (size_t)(t + 2) * kstep; const char* b2 = last ? nB : cB + (size_t)(t + 2) * kstep;
            const char* a3 = a2 + kstep; const char* b3 = b2 + kstep;
            if (last && has_next) S.a_ready(nxt);
            if constexpr (SP2) {
            PG8_LDB(B0, 0, 0); PG8_LDB(B1, 0, 1); PG8_SCHED; PG8_LDA(At, 0, 0); PG8_STAGE(PG8_SA(1, 1), a1 + hstep, voffA);
            PG8_WAIT_V(8); PG8_WAIT_L(0); PG8_BAR; PG8_MMA(0, 0, At, B0); PG8_MMA(0, 1, At, B1); PG8_BAR; PG8_SCHED;
            PG8_LDA(At, 0, 1); PG8_STAGE(PG8_SB(0, 0), b2, voffB); PG8_STAGE(PG8_SB(0, 1), b2 + hstep, voffB); PG8_STAGE(PG8_SA(0, 0), a2, voffA);
            PG8_WAIT_V(8); PG8_WAIT_L(0); PG8_BAR; PG8_MMA(1, 0, At, B0); PG8_MMA(1, 1, At, B1); PG8_BAR; PG8_SCHED;
            PG8_LDB(B0, 1, 0); PG8_LDB(B1, 1, 1); PG8_SCHED; PG8_LDA(At, 1, 0); PG8_STAGE(PG8_SA(0, 1), a2 + hstep, voffA);
            PG8_WAIT_V(8); PG8_WAIT_L(0); PG8_BAR; PG8_MMA(0, 0, At, B0); PG8_MMA(0, 1, At, B1); PG8_BAR; PG8_SCHED;
            PG8_LDA(At, 1, 1); PG8_STAGE(PG8_SB(1, 0), b3, voffB); PG8_STAGE(PG8_SB(1, 1), b3 + hstep, voffB); PG8_STAGE(PG8_SA(1, 0), a3, voffA);
            PG8_WAIT_V(8); PG8_WAIT_L(0); PG8_BAR; PG8_MMA(1, 0, At, B0); PG8_MMA(1, 1, At, B1); PG8_BAR; PG8_SCHED;
            } else {
            PG8_LDB(B0, 0, 0); PG8_SCHED; PG8_LDA(At, 0, 0); PG8_STAGE(PG8_SA(1, 1), a1 + hstep, voffA);
            PG8_WAIT_L(8); PG8_BAR; PG8_WAIT_L(0); PG8_MMA(0, 0, At, B0); PG8_BAR; PG8_SCHED;
            PG8_LDB(B1, 0, 1); PG8_STAGE(PG8_SB(0, 0), b2, voffB);
            PG8_BAR; PG8_WAIT_L(0); PG8_MMA(0, 1, At, B1); PG8_BAR;
            PG8_LDA(At, 0, 1); PG8_STAGE(PG8_SA(0, 0), a2, voffA);
            PG8_BAR; PG8_WAIT_L(0); PG8_MMA(1, 0, At, B0); PG8_BAR; PG8_SCHED;
            PG8_STAGE(PG8_SB(0, 1), b2 + hstep, voffB);
            PG8_WAIT_V(6); PG8_BAR; PG8_MMA(1, 1, At, B1); PG8_BAR;
            PG8_LDB(B0, 1, 0); PG8_SCHED; PG8_LDA(At, 1, 0); PG8_STAGE(PG8_SA(0, 1), a2 + hstep, voffA);
            PG8_WAIT_L(8); PG8_BAR; PG8_WAIT_L(0); PG8_MMA(0, 0, At, B0); PG8_BAR; PG8_SCHED;
            PG8_LDB(B1, 1, 1); PG8_STAGE(PG8_SB(1, 0), b3, voffB);
            PG8_BAR; PG8_WAIT_L(0); PG8_MMA(0, 1, At, B1); PG8_BAR;
            PG8_LDA(At, 1, 1); PG8_STAGE(PG8_SA(1, 0), a3, voffA);
            PG8_BAR; PG8_WAIT_L(0); PG8_MMA(1, 0, At, B0); PG8_BAR; PG8_SCHED;
            PG8_STAGE(PG8_SB(1, 1), b3 + hstep, voffB);
            PG8_WAIT_V(6); PG8_BAR; PG8_MMA(1, 1, At, B1); PG8_BAR;
            }
        }
        if constexpr (ALIGN_EPI) { if (wr == 0) PG8_BAR; }
        if constexpr (!Epi::AFTER_DRAIN) { E(acc, cur, wr, wc, fr, fq); S.done(cur); }
        if (!has_next) break;
#pragma unroll
        for (int a = 0; a < 2; ++a)
#pragma unroll
            for (int b = 0; b < 2; ++b)
#pragma unroll
                for (int m = 0; m < 4; ++m)
#pragma unroll
                    for (int n = 0; n < 2; ++n) acc[a][b][m][n] = (f32x4){0.f, 0.f, 0.f, 0.f};
        cur = nxt; cA = nA; cB = nB; ++ui;
        if constexpr (ALIGN_EPI) { if (wr == 1) PG8_BAR; }
    }
    PG8_WAIT_V(0);
    if constexpr (!ALIGN_EPI) { if (wr == 0) PG8_BAR; }
    PG8_BAR;
    if constexpr (Epi::AFTER_DRAIN) { E.fused(acc, cur, wr, wc, fr, fq, lds, wid, lane); S.done(cur); }
#undef PG8_SA
#undef PG8_SB
#undef PG8_STAGE
#undef PG8_LDA
#undef PG8_LDB
#undef PG8_MMA
#undef PG8_WAIT_V
#undef PG8_WAIT_L
#undef PG8_BAR
#undef PG8_SCHED
}
}
#define GAS __attribute__((address_space(1)))
#define LAS __attribute__((address_space(3)))
typedef unsigned short bf16;
typedef unsigned v4u __attribute__((ext_vector_type(4)));
typedef float f32x4 __attribute__((ext_vector_type(4)));
typedef short bf16x8 __attribute__((ext_vector_type(8)));
typedef GAS unsigned gu32;
typedef GAS unsigned long long gu64;
#define RLX_AGENT __ATOMIC_RELAXED, __HIP_MEMORY_SCOPE_AGENT
#define LDS_WAIT() asm volatile("s_waitcnt lgkmcnt(0)" ::: "memory")
#define VM_WAIT() asm volatile("s_waitcnt vmcnt(0)" ::: "memory")
__device__ __forceinline__ unsigned long long rt() { return __builtin_amdgcn_s_memrealtime(); }
__device__ __forceinline__ unsigned f2bf(float f) { unsigned u = __builtin_bit_cast(unsigned, f); return (u + 0x7fffu + ((u >> 16) & 1u)) >> 16; }
__device__ __forceinline__ unsigned pk2(float lo, float hi) { return f2bf(lo) | (f2bf(hi) << 16); }

#define XB_TMO      128
#define XB_XCNT(j)  (256  + 64 * (j))
#define XB_XSUB(j)  (1280 + 64 * (j))
#define XB_XGEN(j)  (2304 + 64 * (j))
#define XB_TOP      3328
#define XB_TOPGEN   3392
#define XCD_BAR_WORDS 3456
#define XB_SPIN_CAP (1u << 18)

__device__ __forceinline__ unsigned xb_ld(unsigned* p)              { return __hip_atomic_load(p, __ATOMIC_RELAXED, __HIP_MEMORY_SCOPE_AGENT); }
__device__ __forceinline__ unsigned xb_add(unsigned* p, unsigned v) { return __hip_atomic_fetch_add(p, v, __ATOMIC_RELAXED, __HIP_MEMORY_SCOPE_AGENT); }
__device__ __forceinline__ unsigned xb_xcc_id() { return (unsigned)__builtin_amdgcn_s_getreg((3 << 11) | 20) & 0xFu; }
#define XB_SPIN(cond, bar) do { unsigned _sp = 0; while (cond) { __builtin_amdgcn_s_sleep(1); \
    if ((++_sp & 255u) == 0u) { if (xb_ld(&(bar)[XB_TMO])) break; if (_sp > XB_SPIN_CAP) { atomicAdd(&(bar)[XB_TMO], 1u); break; } } } } while (0)

struct XcdBarrier {
    unsigned* bar; unsigned x;
    volatile LAS unsigned* st;
};

__device__ __forceinline__ XcdBarrier xcd_barrier_post(unsigned* bar, volatile LAS unsigned* st) {
    XcdBarrier b; b.bar = bar; b.x = xb_xcc_id(); b.st = st;
    if (threadIdx.x == 0) (void)xb_add(&bar[XB_XCNT(b.x)], 1u);
    return b;
}
__device__ __forceinline__ void xcd_barrier_complete(unsigned* bar, unsigned x, unsigned& nloc, unsigned& nx) {
    const unsigned G = gridDim.x * gridDim.y * gridDim.z;
    unsigned sum, cnt, mine, sp = 0u;
    for (;;) {
        sum = 0u; cnt = 0u; mine = 0u;
#pragma unroll
        for (unsigned j = 0; j < 16; ++j) { const unsigned c = xb_ld(&bar[XB_XCNT(j)]); sum += c; cnt += (c > 0u) ? 1u : 0u; mine = (j == x) ? c : mine; }
        if (sum == G) break;
        __builtin_amdgcn_s_sleep(1);
        if ((++sp & 255u) == 0u) { if (xb_ld(&bar[XB_TMO])) break; if (sp > XB_SPIN_CAP) { atomicAdd(&bar[XB_TMO], 1u); break; } }
    }
    nloc = mine > 0u ? mine : 1u; nx = cnt > 0u ? cnt : 1u;
}

__device__ __forceinline__ void xcd_barrier(const XcdBarrier& b) {
    asm volatile("s_waitcnt vmcnt(0)" ::: "memory");
    __syncthreads();
    if (threadIdx.x == 0) {
        unsigned* bar = b.bar;
        __builtin_amdgcn_s_waitcnt(0);
        unsigned nloc = b.st[0], nx = b.st[1];
        if (nloc == 0u) { xcd_barrier_complete(bar, b.x, nloc, nx); b.st[0] = nloc; b.st[1] = nx; }
        const unsigned old = xb_add(&bar[XB_XSUB(b.x)], 1u);
        const unsigned gen = old / nloc;
        if (old + 1u == (gen + 1u) * nloc) {
            __builtin_amdgcn_fence(__ATOMIC_RELEASE, "agent");
            asm volatile("s_waitcnt vmcnt(0)" ::: "memory");
            const unsigned og = xb_add(&bar[XB_TOP], 1u);
            const unsigned tg = og / nx;
            if (og + 1u == (tg + 1u) * nx) xb_add(&bar[XB_TOPGEN], 1u);
            else XB_SPIN(xb_ld(&bar[XB_TOPGEN]) == tg, bar);
            __builtin_amdgcn_fence(__ATOMIC_ACQUIRE, "agent");
            xb_add(&bar[XB_XGEN(b.x)], 1u);
            asm volatile("s_waitcnt vmcnt(0)" ::: "memory");
        } else {
            XB_SPIN(xb_ld(&bar[XB_XGEN(b.x)]) == gen, bar);
            __builtin_amdgcn_fence(__ATOMIC_ACQUIRE, "agent");
            asm volatile("s_waitcnt vmcnt(0)" ::: "memory");
        }
    }
    __syncthreads();
}
__device__ __forceinline__ float wave_sum(float v) {
#pragma unroll
    for (int o = 1; o < 64; o <<= 1) v += __shfl_xor(v, o);
    return v;
}

constexpr int NWAVES = 8;
#ifndef MK_N_LAUNCHES
#define MK_N_LAUNCHES 1
#endif
#ifndef USE_SIMPLE_ATTN
#define USE_SIMPLE_ATTN 0
#endif
#ifndef USE_SIMPLE_GEMM
#define USE_SIMPLE_GEMM 0
#endif
constexpr int PER_PHASE = 10;
constexpr int N_LAUNCHES = MK_N_LAUNCHES;

constexpr int BATCH = 16, SEQ = 2048, DM = 1024, M = BATCH * SEQ;
constexpr int NQKV = 4608, NGATE = 2048, N1A = NQKV + NGATE;
constexpr int NFW = 512, NF2 = 1024, FF = 4096, AW = 512;
constexpr int F_OFF = 4608, GA_OFF = 5120, IN_WIDTH = 7168;
constexpr float LN_EPS = 1e-5f, ALPHA = 1.189207115002721f, LOG2E = 1.4426950408889634f, C2 = 0.125f * 1.4426950408889634f;

constexpr size_t MiB = 1u << 20;
constexpr size_t WS_CTL = 0, CTL_ZERO_BYTES = 1 * MiB;
constexpr size_t WS_ETAB = 1 * MiB;
constexpr size_t WS_WIN = 2 * MiB, WS_WF = 15 * MiB, WS_WAO = 17 * MiB, WS_WFO = 18 * MiB, WS_WOUT = 19 * MiB, WS_WUP = 21 * MiB, WS_WDN = 29 * MiB, WS_DFT = 37 * MiB;
constexpr size_t WS_QKV = 56 * MiB, WS_G = 344 * MiB;
constexpr size_t WS_MG = 56 * MiB, WS_Z = 120 * MiB, WS_H1 = 344 * MiB, WS_HB = 56 * MiB, WS_END = 512 * MiB;
constexpr size_t OUT_XB = 0, OUT_UT = 64 * MiB, OUT_ATT = 0, OUT_F = 32 * MiB;
constexpr int CW_TMO = 0, CW_CODE = 1, CW_BAR = 4096;

constexpr int RING_OFF = 0, RING_BYTES = 131072;
constexpr int LDSCTL_OFF = RING_BYTES, MISC_OFF = LDSCTL_OFF + 320;
constexpr int TAB_OFF = RING_BYTES + 1024;
constexpr int LDS_BYTES = 147456;

typedef unsigned v2u __attribute__((ext_vector_type(2)));
typedef float f32x16 __attribute__((ext_vector_type(16)));
__device__ __forceinline__ float bflo(unsigned u) { return __builtin_bit_cast(float, u << 16); }
__device__ __forceinline__ float bfhi(unsigned u) { return __builtin_bit_cast(float, u & 0xffff0000u); }
__device__ __forceinline__ v4u pack8(f32x4 a, f32x4 b) { v4u w; w.x = pg8::cvt_pk_bf16(a[0], a[1]); w.y = pg8::cvt_pk_bf16(a[2], a[3]); w.z = pg8::cvt_pk_bf16(b[0], b[1]); w.w = pg8::cvt_pk_bf16(b[2], b[3]); return w; }
__device__ __forceinline__ void unpack8(v4u w, f32x4& a, f32x4& b) { a = (f32x4){bflo(w.x), bfhi(w.x), bflo(w.y), bfhi(w.y)}; b = (f32x4){bflo(w.z), bfhi(w.z), bflo(w.w), bfhi(w.w)}; }

struct Epi1a {
    static constexpr bool PERM = true; bf16* QKV; bf16* G;
    __device__ __forceinline__ void oct(int row, int col, f32x4 v0, f32x4 v1) const {
        if (col < NQKV) { const float sc = col < 1536 ? C2 : 1.0f; *(v4u*)(QKV + (size_t)row * NQKV + col) = pack8(v0 * sc, v1 * sc); }
        else {
#pragma unroll
            for (int j = 0; j < 4; ++j) { v0[j] = __builtin_amdgcn_rcpf(1.0f + __expf(-v0[j])); v1[j] = __builtin_amdgcn_rcpf(1.0f + __expf(-v1[j])); }
            *(v4u*)(G + (size_t)row * NGATE + (col - NQKV)) = pack8(v0, v1); }
    }
    __device__ __forceinline__ void quad(int row, int col, f32x4 v) const {
        if (col < NQKV) { const float sc = col < 1536 ? C2 : 1.0f; v = v * sc; v2u w; w.x = pg8::cvt_pk_bf16(v[0], v[1]); w.y = pg8::cvt_pk_bf16(v[2], v[3]); *(v2u*)(QKV + (size_t)row * NQKV + col) = w; }
        else {
#pragma unroll
            for (int j = 0; j < 4; ++j) v[j] = __builtin_amdgcn_rcpf(1.0f + __expf(-v[j]));
            v2u w; w.x = pg8::cvt_pk_bf16(v[0], v[1]); w.y = pg8::cvt_pk_bf16(v[2], v[3]); *(v2u*)(G + (size_t)row * NGATE + (col - NQKV)) = w; }
    }
};
struct Epi1b {
    static constexpr bool PERM = true; bf16* UT;
    __device__ __forceinline__ size_t idx(int R, int tok) const { return ((size_t)((tok >> 11) * 512 + (R & 511))) * 4096 + (size_t)((R >> 9) * 2048 + (tok & 2047)); }
    __device__ __forceinline__ void oct(int row, int col, f32x4 v0, f32x4 v1) const { *(v4u*)(UT + idx(row, col)) = pack8(v0, v1); }
    __device__ __forceinline__ void quad(int row, int col, f32x4 v) const { v2u w; w.x = pg8::cvt_pk_bf16(v[0], v[1]); w.y = pg8::cvt_pk_bf16(v[2], v[3]); *(v2u*)(UT + idx(row, col)) = w; }
};
struct EpiF {
    static constexpr bool PERM = true; bf16* Fo;
    __device__ __forceinline__ size_t idx(int k1, int bc) const { return ((size_t)((bc >> 9) * 2048 + k1)) * 512 + (size_t)(bc & 511); }
    __device__ __forceinline__ void oct(int row, int col, f32x4 v0, f32x4 v1) const { *(v4u*)(Fo + idx(row, col)) = pack8(v0, v1); }
    __device__ __forceinline__ void quad(int row, int col, f32x4 v) const { v2u w; w.x = pg8::cvt_pk_bf16(v[0], v[1]); w.y = pg8::cvt_pk_bf16(v[2], v[3]); *(v2u*)(Fo + idx(row, col)) = w; }
};
struct EpiGA {
    static constexpr bool PERM = true; const bf16* G; bf16* MG;
    __device__ __forceinline__ void oct(int row, int col, f32x4 v0, f32x4 v1) const {
        f32x4 g0, g1; unpack8(*(const v4u*)(G + (size_t)row * NGATE + col), g0, g1);
        *(v4u*)(MG + (size_t)row * DM + col) = pack8(g0 * v0, g1 * v1); }
    __device__ __forceinline__ void quad(int row, int col, f32x4 v) const {
        const v2u gw = *(const v2u*)(G + (size_t)row * NGATE + col); const f32x4 g = (f32x4){bflo(gw.x), bfhi(gw.x), bflo(gw.y), bfhi(gw.y)}; v = v * g;
        v2u w; w.x = pg8::cvt_pk_bf16(v[0], v[1]); w.y = pg8::cvt_pk_bf16(v[2], v[3]); *(v2u*)(MG + (size_t)row * DM + col) = w; }
};
struct EpiGB {
    static constexpr bool PERM = true; const bf16* G; bf16* MG;
    __device__ __forceinline__ void oct(int row, int col, f32x4 v0, f32x4 v1) const {
        f32x4 g0, g1, m0, m1; unpack8(*(const v4u*)(G + (size_t)row * NGATE + 1024 + col), g0, g1); unpack8(*(const v4u*)(MG + (size_t)row * DM + col), m0, m1);
        *(v4u*)(MG + (size_t)row * DM + col) = pack8(m0 + g0 * v0, m1 + g1 * v1); }
    __device__ __forceinline__ void quad(int row, int col, f32x4 v) const {
        const v2u gw = *(const v2u*)(G + (size_t)row * NGATE + 1024 + col); const f32x4 g = (f32x4){bflo(gw.x), bfhi(gw.x), bflo(gw.y), bfhi(gw.y)};
        const v2u mw = *(const v2u*)(MG + (size_t)row * DM + col); const f32x4 mm = (f32x4){bflo(mw.x), bfhi(mw.x), bflo(mw.y), bfhi(mw.y)}; v = mm + v * g;
        v2u w; w.x = pg8::cvt_pk_bf16(v[0], v[1]); w.y = pg8::cvt_pk_bf16(v[2], v[3]); *(v2u*)(MG + (size_t)row * DM + col) = w; }
};
struct EpiZ1 {
    static constexpr bool PERM = false; const float* x; float* Z;
    __device__ __forceinline__ void quad(int row, int col, f32x4 v) const { const size_t o = (size_t)row * DM + col; *(f32x4*)(Z + o) = *(const f32x4*)(x + o) * ALPHA + v; }
    __device__ __forceinline__ void oct(int row, int col, f32x4 v0, f32x4 v1) const { quad(row, col, v0); quad(row, col + 4, v1); }
};
struct EpiUp {
    static constexpr bool PERM = true; const float* bias; bf16* HB;
    __device__ __forceinline__ void oct(int row, int col, f32x4 v0, f32x4 v1) const {
        v0 = v0 + *(const f32x4*)(bias + col); v1 = v1 + *(const f32x4*)(bias + col + 4);
#pragma unroll
        for (int j = 0; j < 4; ++j) { const float a = fmaxf(v0[j], 0.f), b = fmaxf(v1[j], 0.f); v0[j] = a * a; v1[j] = b * b; }
        *(v4u*)(HB + (size_t)row * FF + col) = pack8(v0, v1); }
    __device__ __forceinline__ void quad(int row, int col, f32x4 v) const {
        v = v + *(const f32x4*)(bias + col);
#pragma unroll
        for (int j = 0; j < 4; ++j) { const float a = fmaxf(v[j], 0.f); v[j] = a * a; }
        v2u w; w.x = pg8::cvt_pk_bf16(v[0], v[1]); w.y = pg8::cvt_pk_bf16(v[2], v[3]); *(v2u*)(HB + (size_t)row * FF + col) = w; }
};
struct EpiZ2 {
    static constexpr bool PERM = false; const bf16* H1; const float* bias; float* Z;
    __device__ __forceinline__ void quad(int row, int col, f32x4 v) const { const size_t o = (size_t)row * DM + col;
        const v2u hw = *(const v2u*)(H1 + o); const f32x4 h = (f32x4){bflo(hw.x), bfhi(hw.x), bflo(hw.y), bfhi(hw.y)};
        *(f32x4*)(Z + o) = h * ALPHA + v + *(const f32x4*)(bias + col); }
    __device__ __forceinline__ void oct(int row, int col, f32x4 v0, f32x4 v1) const { quad(row, col, v0); quad(row, col + 4, v1); }
};

struct Frame {
    LAS unsigned char* lds;
    volatile LAS unsigned* MISC;
    gu32* ctl;
    int tid, lane, wave;
    int vcu, G;
    const float *x, *rel_bias, *w_in, *w_fo, *w_ao, *w_out, *ln1_g, *ln1_b, *w_up, *b_up, *w_down, *b_down, *ln2_g, *ln2_b;
    float* out;
    float* Etab;
    bf16 *WinT, *WfT, *WaoT, *WfoT, *WoutT, *WupT, *WdnT, *DFT;
    bf16 *XB, *UT, *ATT, *FB, *QKV, *GB, *MG, *H1, *HB;
    float* Z;
};

template <class Epi>
__device__ __forceinline__ void gemm_simple_phase(const pg8::Gemm g, const Epi& E, int gw, int ngw, int lane) {
    const int tn = g.N / 64, nt = (g.M / 64) * tn, r = lane & 31, h = lane >> 5;
    for (int t = gw; t < nt; t += ngw) {
        const int pm = t / tn, pn = t % tn;
        f32x16 acc[2][2];
#pragma unroll
        for (int a = 0; a < 2; ++a)
#pragma unroll
            for (int b = 0; b < 2; ++b)
#pragma unroll
                for (int i = 0; i < 16; ++i) acc[a][b][i] = 0.f;
        const bf16* Ap = g.A + (size_t)(pm * 64 + r) * g.K + 8 * h;
        const bf16* Bp = g.Bt + (size_t)(pn * 64 + r) * g.K + 8 * h;
        for (int k = 0; k < g.K; k += 16) {
            const bf16x8 a0 = *(const bf16x8*)(Ap + k), a1 = *(const bf16x8*)(Ap + (size_t)32 * g.K + k);
            const bf16x8 b0 = *(const bf16x8*)(Bp + k), b1 = *(const bf16x8*)(Bp + (size_t)32 * g.K + k);
            acc[0][0] = __builtin_amdgcn_mfma_f32_32x32x16_bf16(b0, a0, acc[0][0], 0, 0, 0);
            acc[0][1] = __builtin_amdgcn_mfma_f32_32x32x16_bf16(b1, a0, acc[0][1], 0, 0, 0);
            acc[1][0] = __builtin_amdgcn_mfma_f32_32x32x16_bf16(b0, a1, acc[1][0], 0, 0, 0);
            acc[1][1] = __builtin_amdgcn_mfma_f32_32x32x16_bf16(b1, a1, acc[1][1], 0, 0, 0);
        }
#pragma unroll
        for (int ri = 0; ri < 2; ++ri)
#pragma unroll
            for (int ci = 0; ci < 2; ++ci)
#pragma unroll
                for (int q4 = 0; q4 < 4; ++q4)
                    E.quad(pm * 64 + 32 * ri + r, pn * 64 + 32 * ci + 8 * q4 + 4 * h, (f32x4){acc[ri][ci][4 * q4], acc[ri][ci][4 * q4 + 1], acc[ri][ci][4 * q4 + 2], acc[ri][ci][4 * q4 + 3]});
    }
}

template <class EF, bool ALIGN>
__device__ __forceinline__ void run_gemm(Frame& F, const bf16* A, const bf16* Bt, int Mm, int Nn, int Kk, const EF& ef) {
    pg8::Gemm g{A, Bt, Mm, Nn, Kk};
#if USE_SIMPLE_GEMM
    gemm_simple_phase<EF>(g, ef, F.vcu * NWAVES + F.wave, F.G * NWAVES, F.lane);
#else
    pg8::StaticOrder S; S.init(Mm, Nn, F.G, (int)blockIdx.x);
    pg8::EpiAdapt<EF> E{ef};
    pg8::gemm_phase<pg8::EpiAdapt<EF>, pg8::StaticOrder, ALIGN, true>(F.lds + RING_OFF, g, S, E);
#endif
}

__device__ __forceinline__ void p0_transpose_item(const float* W, int ld, int K, int ncols, bf16* WT, int row_off, LAS float* scr, int item, int lane) {
    const int nblk = ncols / 32, kb = item / nblk, nb = item % nblk, k0 = 64 * kb, n0 = 32 * nb;
#pragma unroll 8
    for (int i = 0; i < 32; ++i) { const int kk = 2 * i + (lane >> 5); scr[kk * 33 + (lane & 31)] = W[(size_t)(k0 + kk) * ld + n0 + (lane & 31)]; }
    LDS_WAIT(); asm volatile("" ::: "memory");
    const int c = lane & 7;
#pragma unroll
    for (int j = 0; j < 4; ++j) { const int n = (lane >> 3) + 8 * j; const LAS float* s = scr + (8 * c) * 33 + n;
        v4u o; o.x = pk2(s[0 * 33], s[1 * 33]); o.y = pk2(s[2 * 33], s[3 * 33]); o.z = pk2(s[4 * 33], s[5 * 33]); o.w = pk2(s[6 * 33], s[7 * 33]);
        *(GAS v4u*)(WT + (size_t)(row_off + n0 + n) * K + k0 + 8 * c) = o; }
    LDS_WAIT(); asm volatile("" ::: "memory");
}
__device__ __forceinline__ void p0_fold_item(const float* w_in, bf16* WfT, LAS float* scr, int item, int lane) {
    const int half = item & 1, kb = (item >> 1) & 63, g = item >> 7, k0 = 16 * kb;
    LAS float* tw = scr + 16 * 129;
#pragma unroll
    for (int i = 0; i < 2; ++i) { const int j = lane + 64 * i; tw[j] = (half ? sinpif((float)j * (1.0f / 64.0f)) : cospif((float)j * (1.0f / 64.0f))) * 0.08838834764831845f; }
#pragma unroll 8
    for (int i = 0; i < 32; ++i) { const int kk = i >> 1, n2 = (i & 1) * 64 + lane; scr[kk * 129 + n2] = w_in[(size_t)(k0 + kk) * IN_WIDTH + F_OFF + g * 128 + n2]; }
    LDS_WAIT(); asm volatile("" ::: "memory");
    const int kk = lane & 15, sub = lane >> 4;
    for (int j = 0; j < 32; ++j) { const int k2 = sub * 32 + j; float s = 0.f;
#pragma unroll 16
        for (int n2 = 0; n2 < 128; ++n2) s += scr[kk * 129 + n2] * tw[(k2 * n2) & 127];
        WfT[(size_t)(half * 512 + g * 128 + k2) * DM + k0 + kk] = (bf16)f2bf(s); }
    LDS_WAIT(); asm volatile("" ::: "memory");
}
__device__ __forceinline__ int t5_bucket(int rel) {
    const int n = rel < 0 ? -rel : rel; int bk;
    if (n < 8) bk = n; else { bk = 8 + (int)(logf((float)n * 0.125f) / 4.852030263919617f * 8.0f); bk = bk < 15 ? bk : 15; }
    return bk + (rel > 0 ? 16 : 0);
}
__device__ __forceinline__ void p0_prologue(Frame& F) {
    LAS float* scr = (LAS float*)(F.lds + RING_OFF + F.wave * 16384);
    LAS float* ct = (LAS float*)(F.lds + TAB_OFF);
    for (int m = F.tid; m < 2048; m += NWAVES * 64) ct[m] = cospif((float)m * (1.0f / 1024.0f)) * 0.022097086912079608f;
    __syncthreads();
    const int gw = F.vcu * NWAVES + F.wave, NGW = F.G * NWAVES;
    for (int k1 = gw; k1 < SEQ; k1 += NGW) {
#pragma unroll
        for (int j = 0; j < 8; ++j) { const int c8 = (F.lane + 64 * j) * 8, part = c8 >> 11, n1 = c8 & 2047; float v[8];
#pragma unroll
            for (int e = 0; e < 8; ++e) { const int mm = k1 * (n1 + e); v[e] = part ? -ct[(mm - 512) & 2047] : ct[mm & 2047]; }
            v4u o; o.x = pk2(v[0], v[1]); o.y = pk2(v[2], v[3]); o.z = pk2(v[4], v[5]); o.w = pk2(v[6], v[7]);
            *(GAS v4u*)(F.DFT + (size_t)k1 * 4096 + c8) = o; }
    }
    for (int hh = gw; hh < 24; hh += NGW) { const int d = hh < 8 ? 1 : (hh < 16 ? 4 : 16);
#pragma unroll
        for (int i = 0; i < 4; ++i) { const int e = F.lane + 64 * i, rel = e - 128;
            F.Etab[hh * 256 + e] = (rel >= -64 && rel <= 64) ? F.rel_bias[t5_bucket(rel * d) * 24 + hh] * LOG2E : -1.0e30f; } }
    constexpr int I_IN1 = (DM / 64) * (NQKV / 32), I_IN2 = (DM / 64) * (NGATE / 32), I_AO = (AW / 64) * (DM / 32), I_FO = (NFW / 64) * (DM / 32), I_OUT = (DM / 64) * (DM / 32),
                  I_UP = (DM / 64) * (FF / 32), I_DN = (FF / 64) * (DM / 32), I_FOLD = 512;
    constexpr int NITEMS = I_IN1 + I_IN2 + I_AO + I_FO + I_OUT + I_UP + I_DN + I_FOLD;
    for (int it = gw; it < NITEMS; it += NGW) {
        int r = it;
        if (r < I_FOLD) { p0_fold_item(F.w_in, F.WfT, scr, r, F.lane); continue; } r -= I_FOLD;
        if (r < I_IN1) { p0_transpose_item(F.w_in, IN_WIDTH, DM, NQKV, F.WinT, 0, scr, r, F.lane); continue; } r -= I_IN1;
        if (r < I_IN2) { p0_transpose_item(F.w_in + GA_OFF, IN_WIDTH, DM, NGATE, F.WinT, NQKV, scr, r, F.lane); continue; } r -= I_IN2;
        if (r < I_AO) { p0_transpose_item(F.w_ao, DM, AW, DM, F.WaoT, 0, scr, r, F.lane); continue; } r -= I_AO;
        if (r < I_FO) { p0_transpose_item(F.w_fo, DM, NFW, DM, F.WfoT, 0, scr, r, F.lane); continue; } r -= I_FO;
        if (r < I_OUT) { p0_transpose_item(F.w_out, DM, DM, DM, F.WoutT, 0, scr, r, F.lane); continue; } r -= I_OUT;
        if (r < I_UP) { p0_transpose_item(F.w_up, FF, DM, FF, F.WupT, 0, scr, r, F.lane); continue; } r -= I_UP;
        p0_transpose_item(F.w_down, DM, FF, DM, F.WdnT, 0, scr, r, F.lane);
    }
    for (size_t i8 = (size_t)gw * 64 + F.lane; i8 < (size_t)M * DM / 8; i8 += (size_t)NGW * 64) {
        const f32x4 a = *(const GAS f32x4*)(F.x + i8 * 8), b = *(const GAS f32x4*)(F.x + i8 * 8 + 4);
        v4u o; o.x = pk2(a[0], a[1]); o.y = pk2(a[2], a[3]); o.z = pk2(b[0], b[1]); o.w = pk2(b[2], b[3]);
        *(GAS v4u*)(F.XB + i8 * 8) = o; }
}

__device__ __forceinline__ void attn_simple_phase(Frame& F) {
    for (int i = F.vcu * (NWAVES * 64) + F.tid; i < M * 8; i += F.G * NWAVES * 64) {
        const int hg = i >> 15, token = i & (M - 1), b = token >> 11, tt = token & 2047;
        float acc[64];
#pragma unroll
        for (int j = 0; j < 64; ++j) acc[j] = 0.f;
        float mrun = -3.0e38f, l = 0.f;
        for (int g = 0; g < 3; ++g) {
            const int hh = g * 8 + hg, sh = 2 * g, L = SEQ >> sh, r = tt & ((1 << sh) - 1), n = tt >> sh;
            float q[64];
            { const v4u* qp = (const v4u*)(F.QKV + (size_t)token * NQKV + hh * 64);
#pragma unroll
              for (int c = 0; c < 8; ++c) { const v4u w = qp[c]; q[8 * c] = bflo(w.x); q[8 * c + 1] = bfhi(w.x); q[8 * c + 2] = bflo(w.y); q[8 * c + 3] = bfhi(w.y); q[8 * c + 4] = bflo(w.z); q[8 * c + 5] = bfhi(w.z); q[8 * c + 6] = bflo(w.w); q[8 * c + 7] = bfhi(w.w); } }
            const float* et = F.Etab + hh * 256 + 128;
            const int mlo = -64 > -n ? -64 : -n, mhi = 64 < (L - 1 - n) ? 64 : (L - 1 - n);
            for (int m = mlo; m <= mhi; ++m) {
                const bf16* kr = F.QKV + (size_t)(b * SEQ + ((n + m) << sh) + r) * NQKV + 1536 + hh * 64;
                float s = 0.f;
#pragma unroll
                for (int c = 0; c < 8; ++c) { const v4u w = ((const v4u*)kr)[c];
                    s += q[8 * c] * bflo(w.x) + q[8 * c + 1] * bfhi(w.x) + q[8 * c + 2] * bflo(w.y) + q[8 * c + 3] * bfhi(w.y) + q[8 * c + 4] * bflo(w.z) + q[8 * c + 5] * bfhi(w.z) + q[8 * c + 6] * bflo(w.w) + q[8 * c + 7] * bfhi(w.w); }
                s += et[m];
                if (s > mrun) { const float corr = exp2f(mrun - s); l *= corr;
#pragma unroll
                    for (int j = 0; j < 64; ++j) acc[j] *= corr;
                    mrun = s; }
                const float p = exp2f(s - mrun); l += p;
                const bf16* vr = kr + 1536;
#pragma unroll
                for (int c = 0; c < 8; ++c) { const v4u w = ((const v4u*)vr)[c];
                    acc[8 * c] += p * bflo(w.x); acc[8 * c + 1] += p * bfhi(w.x); acc[8 * c + 2] += p * bflo(w.y); acc[8 * c + 3] += p * bfhi(w.y);
                    acc[8 * c + 4] += p * bflo(w.z); acc[8 * c + 5] += p * bfhi(w.z); acc[8 * c + 6] += p * bflo(w.w); acc[8 * c + 7] += p * bfhi(w.w); }
            }
        }
        const float inv = 1.0f / l;
        v4u* op = (v4u*)(F.ATT + (size_t)token * AW + hg * 64);
#pragma unroll
        for (int c = 0; c < 8; ++c) { v4u o; o.x = pk2(acc[8 * c] * inv, acc[8 * c + 1] * inv); o.y = pk2(acc[8 * c + 2] * inv, acc[8 * c + 3] * inv); o.z = pk2(acc[8 * c + 4] * inv, acc[8 * c + 5] * inv); o.w = pk2(acc[8 * c + 6] * inv, acc[8 * c + 7] * inv); op[c] = o; }
    }
}

typedef short s16x4 __attribute__((ext_vector_type(4)));
__device__ __forceinline__ s16x4 lds_tr16(LAS const unsigned char* p) { return __builtin_bit_cast(s16x4, __builtin_amdgcn_ds_read_tr16_b64_v4i16((LAS s16x4*)p)); }
__device__ __forceinline__ float xhalf_max(float v) { auto rr = __builtin_amdgcn_permlane32_swap(__float_as_uint(v), __float_as_uint(v), false, false); return fmaxf(__uint_as_float(rr[0]), __uint_as_float(rr[1])); }
__device__ __forceinline__ float xhalf_sum(float v) { auto rr = __builtin_amdgcn_permlane32_swap(__float_as_uint(v), __float_as_uint(v), false, false); return __uint_as_float(rr[0]) + __uint_as_float(rr[1]); }
constexpr int ATT_ITEMS = BATCH * 24 * 32;
__device__ __forceinline__ void attn_mfma_phase(Frame& F, float* LSE) {
    const int lane = F.lane, q32 = lane & 31, h = lane >> 5;
    const int gw = F.vcu * NWAVES + F.wave, NGW = F.G * NWAVES;
    LAS unsigned char* kl = F.lds + RING_OFF + F.wave * 16384;
    LAS unsigned char* vl = kl + 8192;
    LAS float* et = (LAS float*)(F.lds + TAB_OFF + F.wave * 1024);
    const int vb = (4 * h + ((lane & 15) >> 2)) * 64 + ((lane >> 4) & 1) * 32 + (lane & 3) * 8;
    const int ksw = (q32 >> 1) & 7;
    for (int it = gw; it < ATT_ITEMS; it += NGW) {
        const int b = it / 768, hh = (it >> 5) % 24, w = it & 31;
        const int g = hh >> 3, sh = 2 * g, dd = 1 << sh, nb = 32 >> sh, r = w & (dd - 1), j = w >> sh;
        const size_t rs = (size_t)dd * NQKV;
        const bf16* base = F.QKV + ((size_t)(b * SEQ + r)) * NQKV + hh * 64;
        LDS_WAIT();
#pragma unroll
        for (int i = 0; i < 4; ++i) et[lane + 64 * i] = F.Etab[hh * 256 + lane + 64 * i];
        const int c0 = j > 0 ? j - 1 : 0, c1 = j + 1 < nb ? j + 1 : nb - 1;
        const unsigned rsb = (unsigned)rs * 2u;
        const unsigned koff_e = (unsigned)(lane >> 3) * rsb + (unsigned)(((lane & 7) ^ (lane >> 4)) * 16), koff_o = koff_e ^ 64u;
        const unsigned voff = (unsigned)((lane >> 5) * 8 + ((lane >> 2) & 7)) * rsb + (unsigned)((lane & 3) * 16);
        const char* kbase_u = (const char*)(base + 1536); const char* vbase_u = (const char*)(base + 3072);
#define ATT_DMA_K(c) do { const char* kc_ = kbase_u + (size_t)((c) * 64) * rsb; _Pragma("unroll") for (int i_ = 0; i_ < 8; ++i_) \
            __builtin_amdgcn_global_load_lds((const unsigned*)(kc_ + (size_t)(i_ * 8) * rsb + ((i_ & 1) ? koff_o : koff_e)), (LAS unsigned*)(kl + i_ * 1024), 16, 0, 0); } while (0)
#define ATT_DMA_V(c) do { const char* vc_ = vbase_u + (size_t)((c) * 64) * rsb; _Pragma("unroll") for (int i_ = 0; i_ < 8; ++i_) \
            __builtin_amdgcn_global_load_lds((const unsigned*)(vc_ + (size_t)((i_ & 3) * 16) * rsb + (i_ >> 2) * 64 + voff), (LAS unsigned*)(vl + i_ * 1024), 16, 0, 0); } while (0)
        ATT_DMA_K(c0); ATT_DMA_V(c0);
        bf16x8 qf[2][4];
        { const bf16* qb = base + (size_t)(j * 64 + q32) * rs + 8 * h;
#pragma unroll
          for (int qt = 0; qt < 2; ++qt)
#pragma unroll
              for (int ks = 0; ks < 4; ++ks) qf[qt][ks] = *(const bf16x8*)(qb + (size_t)(qt * 32) * rs + ks * 16); }
        f32x16 o[2][2];
#pragma unroll
        for (int a = 0; a < 2; ++a)
#pragma unroll
            for (int c = 0; c < 2; ++c)
#pragma unroll
                for (int i = 0; i < 16; ++i) o[a][c][i] = 0.f;
        float mrun[2] = {-1.0e30f, -1.0e30f}, lrun[2] = {0.f, 0.f};
        for (int c = c0; c <= c1; ++c) {
            asm volatile("s_waitcnt vmcnt(8)" ::: "memory");
            __builtin_amdgcn_sched_barrier(0);
#pragma unroll
            for (int qt = 0; qt < 2; ++qt) {
                f32x16 s[2];
                { const int eb = 128 + 64 * (c - j) + 4 * h - q32 - qt * 32;
#pragma unroll
                  for (int kt = 0; kt < 2; ++kt)
#pragma unroll
                      for (int i = 0; i < 16; ++i) s[kt][i] = et[eb + kt * 32 + (i & 3) + 8 * (i >> 2)]; }
#pragma unroll
                for (int ks = 0; ks < 4; ++ks) {
                    const bf16x8 k0 = *(const LAS bf16x8*)(kl + q32 * 128 + (((2 * ks + h) ^ ksw) * 16));
                    const bf16x8 k1 = *(const LAS bf16x8*)(kl + 4096 + q32 * 128 + (((2 * ks + h) ^ ksw) * 16));
                    s[0] = __builtin_amdgcn_mfma_f32_32x32x16_bf16(k0, qf[qt][ks], s[0], 0, 0, 0);
                    s[1] = __builtin_amdgcn_mfma_f32_32x32x16_bf16(k1, qf[qt][ks], s[1], 0, 0, 0);
                }
                if (qt == 1) { LDS_WAIT(); __builtin_amdgcn_sched_barrier(0); if (c < c1) ATT_DMA_K(c + 1); }
                float mx = s[0][0];
#pragma unroll
                for (int i = 1; i < 16; ++i) mx = fmaxf(mx, s[0][i]);
#pragma unroll
                for (int i = 0; i < 16; ++i) mx = fmaxf(mx, s[1][i]);
                mx = xhalf_max(mx);
                const float mn = fmaxf(mrun[qt], mx), alpha = __builtin_amdgcn_exp2f(mrun[qt] - mn);
                mrun[qt] = mn;
                float ps = 0.f;
#pragma unroll
                for (int kt = 0; kt < 2; ++kt)
#pragma unroll
                    for (int i = 0; i < 16; ++i) { const float p = __builtin_amdgcn_exp2f(s[kt][i] - mn); s[kt][i] = p; ps += p; }
                lrun[qt] = lrun[qt] * alpha + ps;
#pragma unroll
                for (int dt = 0; dt < 2; ++dt)
#pragma unroll
                    for (int i = 0; i < 16; ++i) o[dt][qt][i] *= alpha;
                bf16x8 pf[4];
#pragma unroll
                for (int s16 = 0; s16 < 4; ++s16) { const int kt = s16 >> 1, o8 = 8 * (s16 & 1); v4u pw;
                    pw.x = pg8::cvt_pk_bf16(s[kt][o8], s[kt][o8 + 1]); pw.y = pg8::cvt_pk_bf16(s[kt][o8 + 2], s[kt][o8 + 3]);
                    pw.z = pg8::cvt_pk_bf16(s[kt][o8 + 4], s[kt][o8 + 5]); pw.w = pg8::cvt_pk_bf16(s[kt][o8 + 6], s[kt][o8 + 7]);
                    pf[s16] = __builtin_bit_cast(bf16x8, pw); }
                if (qt == 0) { asm volatile("s_waitcnt vmcnt(0)" ::: "memory"); __builtin_amdgcn_sched_barrier(0); }
#pragma unroll
                for (int dt = 0; dt < 2; ++dt)
#pragma unroll
                    for (int s16 = 0; s16 < 4; ++s16) {
                        const s16x4 lo = lds_tr16(vl + vb + dt * 4096 + s16 * 1024), hi = lds_tr16(vl + vb + dt * 4096 + s16 * 1024 + 512);
                        const bf16x8 vf = (bf16x8){lo[0], lo[1], lo[2], lo[3], hi[0], hi[1], hi[2], hi[3]};
                        o[dt][qt] = __builtin_amdgcn_mfma_f32_32x32x16_bf16(vf, pf[s16], o[dt][qt], 0, 0, 0);
                    }
            }
            LDS_WAIT(); __builtin_amdgcn_sched_barrier(0);
            if (c < c1) ATT_DMA_V(c + 1);
        }
#undef ATT_DMA_K
#undef ATT_DMA_V
#pragma unroll
        for (int qt = 0; qt < 2; ++qt) {
            const float lt = xhalf_sum(lrun[qt]), inv = 1.0f / lt;
            const int n = j * 64 + qt * 32 + q32;
            bf16* orow = (bf16*)base + (size_t)n * rs + 4 * h;
#pragma unroll
            for (int dt = 0; dt < 2; ++dt)
#pragma unroll
                for (int q4 = 0; q4 < 4; ++q4) { v2u wv; wv.x = pg8::cvt_pk_bf16(o[dt][qt][4 * q4] * inv, o[dt][qt][4 * q4 + 1] * inv); wv.y = pg8::cvt_pk_bf16(o[dt][qt][4 * q4 + 2] * inv, o[dt][qt][4 * q4 + 3] * inv);
                    *(v2u*)(orow + dt * 32 + 8 * q4) = wv; }
            if (h == 0) LSE[((size_t)g * M + (size_t)(b * SEQ + n * dd + r)) * 8 + (hh & 7)] = mrun[qt] + __builtin_amdgcn_logf(lt);
        }
    }
}
__device__ __forceinline__ void attn_merge_phase(Frame& F, const float* LSE) {
    for (int i = F.vcu * (NWAVES * 64) + F.tid; i < M * 64; i += F.G * NWAVES * 64) {
        const int token = i >> 6, hg = (i >> 3) & 7, d8 = i & 7;
        const float l0 = LSE[((size_t)0 * M + token) * 8 + hg], l1 = LSE[((size_t)1 * M + token) * 8 + hg], l2 = LSE[((size_t)2 * M + token) * 8 + hg];
        const float mx = fmaxf(l0, fmaxf(l1, l2));
        float w0 = __builtin_amdgcn_exp2f(l0 - mx), w1 = __builtin_amdgcn_exp2f(l1 - mx), w2 = __builtin_amdgcn_exp2f(l2 - mx);
        const float inv = 1.0f / (w0 + w1 + w2); w0 *= inv; w1 *= inv; w2 *= inv;
        const bf16* qrow = F.QKV + (size_t)token * NQKV + hg * 64 + d8 * 8;
        f32x4 a0, a1, b0, b1, c0, c1;
        unpack8(*(const v4u*)(qrow), a0, a1); unpack8(*(const v4u*)(qrow + 512), b0, b1); unpack8(*(const v4u*)(qrow + 1024), c0, c1);
        *(v4u*)(F.ATT + (size_t)token * AW + hg * 64 + d8 * 8) = pack8(a0 * w0 + b0 * w1 + c0 * w2, a1 * w0 + b1 * w1 + c1 * w2);
    }
}

template <bool TO_BF16>
__device__ __forceinline__ void ln_rows_phase(Frame& F, const float* Z, const float* gam, const float* bet, bf16* ob, float* of) {
    const int gw = F.vcu * NWAVES + F.wave, NGW = F.G * NWAVES;
    f32x4 gv[4], bv[4];
#pragma unroll
    for (int j = 0; j < 4; ++j) { gv[j] = *(const GAS f32x4*)(gam + (F.lane + 64 * j) * 4); bv[j] = *(const GAS f32x4*)(bet + (F.lane + 64 * j) * 4); }
    for (int m = gw; m < M; m += NGW) {
        const GAS f32x4* xr = (const GAS f32x4*)(Z + (size_t)m * DM) + F.lane;
        f32x4 v[4]; float s = 0.f;
#pragma unroll
        for (int j = 0; j < 4; ++j) { v[j] = xr[64 * j]; s += (v[j].x + v[j].y) + (v[j].z + v[j].w); }
        const float mean = wave_sum(s) * (1.f / DM); float s2 = 0.f;
#pragma unroll
        for (int j = 0; j < 4; ++j) { v[j] = v[j] - mean; s2 += (v[j].x * v[j].x + v[j].y * v[j].y) + (v[j].z * v[j].z + v[j].w * v[j].w); }
        const float rstd = 1.f / sqrtf(wave_sum(s2) * (1.f / DM) + LN_EPS);
#pragma unroll
        for (int j = 0; j < 4; ++j) { const f32x4 o = v[j] * rstd * gv[j] + bv[j];
            if (TO_BF16) { v2u w; w.x = pk2(o[0], o[1]); w.y = pk2(o[2], o[3]); *((GAS v2u*)(ob + (size_t)m * DM) + F.lane + 64 * j) = w; }
            else *((GAS f32x4*)(of + (size_t)m * DM) + F.lane + 64 * j) = o; }
    }
}


__device__ __forceinline__ void probe_bf16(Frame& F, const bf16* src, size_t n) {
    for (size_t i = (size_t)F.vcu * (NWAVES * 64) + F.tid; i < (size_t)M * DM; i += (size_t)F.G * NWAVES * 64) F.out[i] = bflo((unsigned)src[i % n]);
}
struct Args { const float* in[14]; float* out; unsigned char* ws; int ph_lo, ph_hi, li, pad; };
__global__ void __launch_bounds__(NWAVES * 64, 2) fwd_kernel(Args args) {
    extern __shared__ __attribute__((aligned(16))) unsigned char lds[];
    Frame F;
    F.lds = (LAS unsigned char*)lds;
    F.MISC = (volatile LAS unsigned*)(F.lds + MISC_OFF);
    F.tid = threadIdx.x; F.lane = F.tid & 63; F.wave = __builtin_amdgcn_readfirstlane(F.tid >> 6);
    F.G = gridDim.x; { const int bx = blockIdx.x; F.vcu = (F.G % 8 == 0) ? (bx % 8) * (F.G / 8) + bx / 8 : bx; }
#define GRID_BAR(seam) do { if (N_LAUNCHES == PER_PHASE) { if (F.tid == 0) __hip_atomic_store(F.ctl + CW_TMO, 0xBADBA0u | (unsigned)(seam), RLX_AGENT); } \
    else { xcd_barrier(bar); } } while (0)
    unsigned char* ws = args.ws; unsigned char* ob = (unsigned char*)args.out;
    F.ctl = (gu32*)(ws + WS_CTL);
    F.x = args.in[0]; F.rel_bias = args.in[1]; F.w_in = args.in[2]; F.w_fo = args.in[3]; F.w_ao = args.in[4]; F.w_out = args.in[5]; F.ln1_g = args.in[6]; F.ln1_b = args.in[7];
    F.w_up = args.in[8]; F.b_up = args.in[9]; F.w_down = args.in[10]; F.b_down = args.in[11]; F.ln2_g = args.in[12]; F.ln2_b = args.in[13]; F.out = args.out;
    F.Etab = (float*)(ws + WS_ETAB);
    F.WinT = (bf16*)(ws + WS_WIN); F.WfT = (bf16*)(ws + WS_WF); F.WaoT = (bf16*)(ws + WS_WAO); F.WfoT = (bf16*)(ws + WS_WFO); F.WoutT = (bf16*)(ws + WS_WOUT);
    F.WupT = (bf16*)(ws + WS_WUP); F.WdnT = (bf16*)(ws + WS_WDN); F.DFT = (bf16*)(ws + WS_DFT);
    F.XB = (bf16*)(ob + OUT_XB); F.UT = (bf16*)(ob + OUT_UT); F.ATT = (bf16*)(ob + OUT_ATT); F.FB = (bf16*)(ob + OUT_F);
    F.QKV = (bf16*)(ws + WS_QKV); F.GB = (bf16*)(ws + WS_G); F.MG = (bf16*)(ws + WS_MG); F.H1 = (bf16*)(ws + WS_H1); F.HB = (bf16*)(ws + WS_HB); F.Z = (float*)(ws + WS_Z);
    for (int u = F.tid; u < (LDS_BYTES - LDSCTL_OFF) / 4; u += NWAVES * 64) ((LAS unsigned*)(F.lds + LDSCTL_OFF))[u] = 0u;
    __syncthreads();
    const int bli = (N_LAUNCHES == PER_PHASE) ? 0 : args.li;
    XcdBarrier bar; bar.bar = (unsigned*)(F.ctl + CW_BAR) + bli * XCD_BAR_WORDS; bar.x = 0; bar.st = nullptr;
    if (N_LAUNCHES != PER_PHASE) bar = xcd_barrier_post((unsigned*)(F.ctl + CW_BAR) + bli * XCD_BAR_WORDS, F.MISC + 8);
    const int lo = args.ph_lo, hi = args.ph_hi;
#ifdef PROBE_LAST
#define IN(k) (lo <= (k) && (k) < hi && (k) <= PROBE_LAST)
    {
        bf16* tmp = (bf16*)(ws + 472 * MiB);
        if (lo <= PROBE_LAST + 1 && PROBE_LAST + 1 < hi) { const bf16* src = PROBE_PTR; for (size_t i = (size_t)F.vcu * (NWAVES * 64) + F.tid; i < (size_t)(PROBE_N); i += (size_t)F.G * NWAVES * 64) tmp[i] = src[(size_t)(PROBE_OFF) + i]; }
        if (lo <= PROBE_LAST + 2 && PROBE_LAST + 2 < hi) probe_bf16(F, tmp, (size_t)(PROBE_N));
    }
#else
#define IN(k) (lo <= (k) && (k) < hi)
#endif
#define BOTH(k) (IN(k) && IN((k) + 1))

    if (IN(0)) { p0_prologue(F); if (BOTH(0)) GRID_BAR(0); }
    if (IN(1)) {
        { Epi1a e{F.QKV, F.GB}; run_gemm<Epi1a, true>(F, F.XB, F.WinT, M, N1A, DM, e); }
        { Epi1b e{F.UT}; run_gemm<Epi1b, true>(F, F.WfT, F.XB, NF2, M, DM, e); }
        if (BOTH(1)) GRID_BAR(1);
    }
    float* LSEB = (float*)(ws + 472 * MiB);
    if (IN(2)) {
#if USE_SIMPLE_ATTN
        attn_simple_phase(F);
#else
        attn_mfma_phase(F, LSEB);
#endif
        if (BOTH(2)) GRID_BAR(2);
    }
    if (IN(3)) {
#if !USE_SIMPLE_ATTN
        attn_merge_phase(F, LSEB);
        __syncthreads();
#endif
        { EpiF e{F.FB}; run_gemm<EpiF, true>(F, F.DFT, F.UT, SEQ, BATCH * NFW, 2 * SEQ, e); }
        if (BOTH(3)) GRID_BAR(3);
    }
    if (IN(4)) {
        { EpiGA e{F.GB, F.MG}; run_gemm<EpiGA, true>(F, F.ATT, F.WaoT, M, DM, AW, e); }
        VM_WAIT(); __syncthreads();
        { EpiGB e{F.GB, F.MG}; run_gemm<EpiGB, true>(F, F.FB, F.WfoT, M, DM, NFW, e); }
        if (BOTH(4)) GRID_BAR(4);
    }
    if (IN(5)) {
        { EpiZ1 e{F.x, F.Z}; run_gemm<EpiZ1, true>(F, F.MG, F.WoutT, M, DM, DM, e); }
        if (BOTH(5)) GRID_BAR(5);
    }
    if (IN(6)) { ln_rows_phase<true>(F, F.Z, F.ln1_g, F.ln1_b, F.H1, nullptr); if (BOTH(6)) GRID_BAR(6); }
    if (IN(7)) {
        { EpiUp e{F.b_up, F.HB}; run_gemm<EpiUp, true>(F, F.H1, F.WupT, M, FF, DM, e); }
        if (BOTH(7)) GRID_BAR(7);
    }
    if (IN(8)) {
        { EpiZ2 e{F.H1, F.b_down, F.out}; run_gemm<EpiZ2, true>(F, F.HB, F.WdnT, M, DM, FF, e); }
        if (BOTH(8)) GRID_BAR(8);
    }
    if (IN(9)) { ln_rows_phase<false>(F, F.out, F.ln2_g, F.ln2_b, nullptr, F.out); }
#undef IN
#undef BOTH
}

extern "C" void kernel_launch(void* const* d_in, const int* in_sizes, int n_in, void* d_out, int out_size, void* d_ws, size_t ws_size, hipStream_t stream) {
    static int grid = 0;
    if (grid == 0) {
        if (n_in != 14 || in_sizes[0] != M * DM || out_size != M * DM || ws_size < WS_END) { fprintf(stderr, "kernel_launch: unexpected shapes / workspace (n_in %d, in0 %d, out %d, ws %zu); nothing launched\n", n_in, n_in > 0 ? in_sizes[0] : -1, out_size, ws_size); grid = -1; return; }
        int dev = 0, cus = 0, per_cu = 0;
        if (hipGetDevice(&dev) != hipSuccess || hipDeviceGetAttribute(&cus, hipDeviceAttributeMultiprocessorCount, dev) != hipSuccess) { grid = -1; return; }
        if (hipFuncSetAttribute((const void*)fwd_kernel, hipFuncAttributeMaxDynamicSharedMemorySize, LDS_BYTES) != hipSuccess) { fprintf(stderr, "kernel_launch: hipFuncSetAttribute failed\n"); grid = -1; return; }
        if (hipOccupancyMaxActiveBlocksPerMultiprocessor(&per_cu, (const void*)fwd_kernel, NWAVES * 64, LDS_BYTES) != hipSuccess || per_cu < 1)
            fprintf(stderr, "kernel_launch: note: occupancy query reports %d workgroups per CU\n", per_cu);
        (void)hipGetLastError();
        grid = cus;
    }
    if (grid < 0) return;
    if (hipMemsetAsync((char*)d_ws + WS_CTL, 0, CTL_ZERO_BYTES, stream) != hipSuccess) { fprintf(stderr, "kernel_launch: hipMemsetAsync failed\n"); return; }
    Args a{};
    for (int i = 0; i < 14; ++i) a.in[i] = (const float*)d_in[i];
    a.out = (float*)d_out; a.ws = (unsigned char*)d_ws;
    for (int li = 0; li < N_LAUNCHES; ++li) {
        a.ph_lo = (N_LAUNCHES == PER_PHASE) ? li : 0; a.ph_hi = (N_LAUNCHES == PER_PHASE) ? li + 1 : PER_PHASE; a.li = (N_LAUNCHES == PER_PHASE) ? 0 : li;
        hipLaunchKernelGGL(fwd_kernel, dim3(grid), dim3(NWAVES * 64), LDS_BYTES, stream, a);
        const hipError_t le = hipPeekAtLastError();
        if (le != hipSuccess) { fprintf(stderr, "kernel_launch: launch %d failed: %s\n", li, hipGetErrorName(le)); break; }
    }
}
```
